# Optimizing an MI355X kernel written in HIP

```python
import math
import jax, jax.numpy as jnp
from jax import lax
import numpy as np

D_MODEL = 2048
BATCH = 1
SEQ = 8192
DEPTH = 2

CHUNK = 64
Q_BLOCK = 128
HEAD_DIM = 128
N_BRANCH = 4
BRANCH_WIDTH = D_MODEL // N_BRANCH
N_HEADS = BRANCH_WIDTH // HEAD_DIM
LRU_WIDTH = BRANCH_WIDTH
LRU_BLOCKS = N_HEADS
LRU_BLOCK = LRU_WIDTH // LRU_BLOCKS
CONV_WIDTH = 4
LRU_C = 8.0
LOOKBACK_CHUNKS = 8
BAND_CHUNKS = LOOKBACK_CHUNKS + 1
REL_CLIP = 256
REL_TABLE = REL_CLIP + CHUNK
D_FF = 4 * D_MODEL
ALPHA = (2.0 * DEPTH) ** 0.25
BETA = (8.0 * DEPTH) ** -0.25
LN_EPS = 1e-5

IN_SIZES = (
    BRANCH_WIDTH, BRANCH_WIDTH, BRANCH_WIDTH, N_HEADS,
    LRU_WIDTH, LRU_WIDTH,
    BRANCH_WIDTH, BRANCH_WIDTH, BRANCH_WIDTH,
    BRANCH_WIDTH, BRANCH_WIDTH, BRANCH_WIDTH,
)
D_IN = sum(IN_SIZES)

kernel_name = "chunk_causal_hybrid_fox_rglru_stickbreak_chunkattn"

F32 = jnp.float32


def layer_norm(x, g, b):
    xf = x.astype(F32)
    mu = jnp.mean(xf, axis=-1, keepdims=True)
    var = jnp.mean(jnp.square(xf - mu), axis=-1, keepdims=True)
    y = (xf - mu) * lax.rsqrt(var + LN_EPS) * g.astype(F32) + b.astype(F32)
    return y.astype(x.dtype)


def split_cols(u, sizes):
    outs, off = [], 0
    for n in sizes:
        outs.append(u[..., off:off + n])
        off += n
    return outs


def heads(t):
    b, s, _ = t.shape
    return t.reshape(b, s, N_HEADS, HEAD_DIM)


def fox_attention(q, k, v, f_logit):
    B, S, H, Dh = q.shape
    nb = S // Q_BLOCK
    cum_f = jnp.cumsum(jax.nn.log_sigmoid(f_logit.astype(F32)), axis=1)
    cum_f_k = cum_f.transpose(0, 2, 1)
    qb = q.reshape(B, nb, Q_BLOCK, H, Dh).transpose(1, 0, 2, 3, 4)
    fb = cum_f.reshape(B, nb, Q_BLOCK, H).transpose(1, 0, 3, 2)
    kpos = jnp.arange(S)
    scale = Dh ** -0.5

    def block(args):
        i, qi, fi = args
        s = jnp.einsum('bqhd,bkhd->bhqk', qi, k).astype(F32) * scale
        s = s + fi[..., :, None] - cum_f_k[:, :, None, :]
        qpos = i * Q_BLOCK + jnp.arange(Q_BLOCK)
        s = jnp.where(kpos[None, :] <= qpos[:, None], s, -jnp.inf)
        p = jax.nn.softmax(s, axis=-1)
        return jnp.einsum('bhqk,bkhd->bqhd', p.astype(v.dtype), v)

    out = lax.map(block, (jnp.arange(nb), qb, fb))
    return out.transpose(1, 0, 2, 3, 4).reshape(B, S, H * Dh)


def stick_breaking_attention(q, k, v):
    B, S, H, Dh = q.shape
    nb = S // Q_BLOCK
    qb = q.reshape(B, nb, Q_BLOCK, H, Dh).transpose(1, 0, 2, 3, 4)
    kpos = jnp.arange(S)
    scale = Dh ** -0.5

    def block(args):
        i, qi = args
        z = jnp.einsum('bqhd,bkhd->bhqk', qi, k).astype(F32) * scale
        qpos = i * Q_BLOCK + jnp.arange(Q_BLOCK)
        mask = kpos[None, :] < qpos[:, None]
        log_1m_beta = jnp.where(mask, jax.nn.log_sigmoid(-z), 0.0)
        later = lax.cumsum(log_1m_beta, axis=3, reverse=True) - log_1m_beta
        a = jnp.where(mask, jnp.exp(jax.nn.log_sigmoid(z) + later), 0.0)
        return jnp.einsum('bhqk,bkhd->bqhd', a.astype(v.dtype), v)

    out = lax.map(block, (jnp.arange(nb), qb))
    return out.transpose(1, 0, 2, 3, 4).reshape(B, S, H * Dh)


def chunk_band_attention(q, k, v, rel_bias):
    B, S, H, Dh = q.shape
    nc = S // CHUNK
    qc = q.reshape(B, nc, CHUNK, H, Dh)
    pad = ((0, 0), (LOOKBACK_CHUNKS, 0), (0, 0), (0, 0), (0, 0))
    kc = jnp.pad(k.reshape(B, nc, CHUNK, H, Dh), pad)
    vc = jnp.pad(v.reshape(B, nc, CHUNK, H, Dh), pad)
    kband = jnp.concatenate([kc[:, j:j + nc] for j in range(BAND_CHUNKS)], axis=2)
    vband = jnp.concatenate([vc[:, j:j + nc] for j in range(BAND_CHUNKS)], axis=2)
    kidx = jnp.arange(BAND_CHUNKS * CHUNK)
    dist = LOOKBACK_CHUNKS * CHUNK + jnp.arange(CHUNK)[:, None] - kidx[None, :]
    ridx = jnp.clip(dist, -(CHUNK - 1), REL_CLIP) + (CHUNK - 1)
    bias = rel_bias.astype(F32)[:, ridx]
    chunk_of_slot = jnp.arange(nc)[:, None] - LOOKBACK_CHUNKS + jnp.arange(BAND_CHUNKS)[None, :]
    valid = jnp.repeat(chunk_of_slot >= 0, CHUNK, axis=1)
    s = jnp.einsum('bcqhd,bckhd->bchqk', qc, kband).astype(F32) * (Dh ** -0.5)
    s = s + bias[None, None]
    s = jnp.where(valid[None, :, None, None, :], s, -jnp.inf)
    p = jax.nn.softmax(s, axis=-1)
    out = jnp.einsum('bchqk,bckhd->bcqhd', p.astype(v.dtype), vband)
    return out.reshape(B, S, H * Dh)


def recurrent_branch(xr, yr, conv_w, conv_b, w_r, b_r, w_i, b_i, lam):
    B, S, W = xr.shape
    xp = jnp.pad(xr, ((0, 0), (CONV_WIDTH - 1, 0), (0, 0)))
    xc = conv_b
    for j in range(CONV_WIDTH):
        xc = xc + xp[:, j:j + S] * conv_w[j]
    xg = xc.reshape(B, S, LRU_BLOCKS, LRU_BLOCK)
    r = jax.nn.sigmoid(jnp.einsum('bsnc,ncd->bsnd', xg, w_r).reshape(B, S, W) + b_r)
    gi = jax.nn.sigmoid(jnp.einsum('bsnc,ncd->bsnd', xg, w_i).reshape(B, S, W) + b_i)
    log_a = LRU_C * r.astype(F32) * jax.nn.log_sigmoid(lam.astype(F32))
    a = jnp.exp(log_a)
    inp = jnp.sqrt(-jnp.expm1(2.0 * log_a)) * (gi * xc).astype(F32)

    def combine(left, right):
        a1, b1 = left
        a2, b2 = right
        return a1 * a2, a2 * b1 + b2

    _, h = lax.associative_scan(combine, (a, inp), axis=1)
    return h.astype(xr.dtype) * jax.nn.gelu(yr)


def setup_inputs(seed: int = 0) -> dict:
    key = jax.random.key(seed)
    ks = jax.random.split(key, 24)
    L, D, Wb = DEPTH, D_MODEL, BRANCH_WIDTH

    def nrm(k, shape, scale):
        return jax.random.normal(k, shape, F32) * scale

    u = jax.random.uniform(ks[9], (L, LRU_WIDTH), F32, 0.9, 0.999)
    a0 = u ** (1.0 / LRU_C)
    lru_lambda = jnp.log(a0) - jnp.log1p(-a0)
    return {
        "x": nrm(ks[0], (BATCH, SEQ, D), 1.0),
        "ln_in_g": 1.0 + nrm(ks[1], (D,), 0.02),
        "ln_in_b": nrm(ks[2], (D,), 0.02),
        "w_in": nrm(ks[3], (L, D, D_IN), D ** -0.5),
        "b_forget": 3.0 + nrm(ks[4], (L, N_HEADS), 0.5),
        "conv_w": nrm(ks[5], (L, CONV_WIDTH, LRU_WIDTH), CONV_WIDTH ** -0.5),
        "conv_b": nrm(ks[6], (L, LRU_WIDTH), 0.02),
        "w_r": nrm(ks[7], (L, LRU_BLOCKS, LRU_BLOCK, LRU_BLOCK), LRU_BLOCK ** -0.5),
        "b_r": nrm(ks[8], (L, LRU_WIDTH), 0.02),
        "w_i": nrm(ks[10], (L, LRU_BLOCKS, LRU_BLOCK, LRU_BLOCK), LRU_BLOCK ** -0.5),
        "b_i": nrm(ks[11], (L, LRU_WIDTH), 0.02),
        "lru_lambda": lru_lambda,
        "rel_bias": nrm(ks[12], (L, N_HEADS, REL_TABLE), 0.1),
        "w_branch": nrm(ks[13], (L, N_BRANCH, Wb, D), Wb ** -0.5),
        "w_gate": nrm(ks[14], (L, N_BRANCH, D, D), D ** -0.5),
        "b_gate": nrm(ks[15], (L, N_BRANCH, D), 0.02),
        "w_out": nrm(ks[16], (L, D, D), BETA * D ** -0.5),
        "ln1_g": 1.0 + nrm(ks[17], (L, D), 0.02),
        "ln1_b": nrm(ks[18], (L, D), 0.02),
        "w_ff1": nrm(ks[19], (L, D, D_FF), D ** -0.5),
        "w_ff2": nrm(ks[20], (L, D_FF, D), BETA * D_FF ** -0.5),
        "ln2_g": 1.0 + nrm(ks[21], (L, D), 0.02),
        "ln2_b": nrm(ks[22], (L, D), 0.02),
    }


def reference(x, ln_in_g, ln_in_b, w_in, b_forget, conv_w, conv_b, w_r, b_r, w_i, b_i,
              lru_lambda, rel_bias, w_branch, w_gate, b_gate, w_out, ln1_g, ln1_b,
              w_ff1, w_ff2, ln2_g, ln2_b):
    x = layer_norm(x, ln_in_g, ln_in_b)
    for l in range(DEPTH):
        u = x @ w_in[l]
        (fq, fk, fv, ff, rx, ry, sq, sk, sv, cq, ck, cv) = split_cols(u, IN_SIZES)
        o_fox = fox_attention(heads(fq), heads(fk), heads(fv), ff + b_forget[l])
        o_lru = recurrent_branch(rx, ry, conv_w[l], conv_b[l], w_r[l], b_r[l],
                                 w_i[l], b_i[l], lru_lambda[l])
        o_sb = stick_breaking_attention(heads(sq), heads(sk), heads(sv))
        o_ch = chunk_band_attention(heads(cq), heads(ck), heads(cv), rel_bias[l])
        merged = None
        for g, o in enumerate((o_fox, o_lru, o_sb, o_ch)):
            gate = jax.nn.sigmoid(x @ w_gate[l, g] + b_gate[l, g])
            term = gate * (o @ w_branch[l, g])
            merged = term if merged is None else merged + term
        x = layer_norm(ALPHA * x + merged @ w_out[l], ln1_g[l], ln1_b[l])
        hid = jnp.square(jax.nn.relu(x @ w_ff1[l]))
        x = layer_norm(ALPHA * x + hid @ w_ff2[l], ln2_g[l], ln2_b[l])
    return x
```

```cpp
#include <hip/hip_runtime.h>
#include <hip/hip_cooperative_groups.h>
#include <cstdio>
#include <cstdint>
namespace cg = cooperative_groups;
__device__ __forceinline__ int tid_fresh() { int t = threadIdx.x; asm volatile("" : "+v"(t)); return t; }
namespace pg8 {
#define PG8_LAS __attribute__((address_space(3)))
typedef unsigned short bf16_t;
typedef short bf16x8 __attribute__((ext_vector_type(8)));
typedef float f32x4 __attribute__((ext_vector_type(4)));
typedef unsigned u32x4 __attribute__((ext_vector_type(4)));
constexpr int BM = 256, BK = 64, HALF = 128, HTB = HALF * BK * 2  , STAGE_BYTES = 8 * HTB, NXCD = 8, WGM = 8;

__host__ __device__ __forceinline__ int lds_byte(int r, int c) { const int st = (r >> 4) * 2 + (c >> 5), rr = r & 15, cc = c & 31, ob = rr * 64 + cc * 2; return st * 1024 + (ob ^ (((ob >> 9) & 1) << 5)); }
__host__ __device__ __forceinline__ void stage_rc(int b, int& R, int& C) { const int st = b / 1024, sb = b % 1024, swz = sb ^ (((sb >> 9) & 1) << 5); R = (st >> 1) * 16 + swz / 64; C = (st & 1) * 32 + (swz % 64) / 2; }
__host__ __device__ __forceinline__ int perm32(int rho) { const int n = rho >> 4, i = rho & 15; return 8 * (i >> 2) + 4 * n + (i & 3); }

struct Unit { int pm, pn; };
struct Gemm { const bf16_t* A; const bf16_t* Bt; int M, N, K; };

struct StaticOrder {
    int nM, nN, nwg, G, c;
    __host__ __device__ void init(int M, int N, int G_, int c_) { nM = M / BM; nN = N / BM; nwg = nM * nN; G = G_; c = c_; }
    __host__ __device__ bool next(int i, Unit& u) const {
        const long L = (long)i * G + c; if (L >= nwg) return false;
        int wgid = (int)L; { const int q = nwg / NXCD, r = nwg % NXCD, xcd = wgid % NXCD, off = wgid / NXCD; wgid = (xcd < r ? xcd * (q + 1) : r * (q + 1) + (xcd - r) * q) + off; }
        const int nig = WGM * nN, gid = wgid / nig, fm = gid * WGM, gsz = (nM - fm) < WGM ? (nM - fm) : WGM;
        u.pm = fm + ((wgid % nig) % gsz); u.pn = (wgid % nig) / gsz; return true;
    }
    __device__ __forceinline__ void a_ready(const Unit&) const {}
    __device__ __forceinline__ void done(const Unit&) const {}
};

__device__ __forceinline__ unsigned cvt_pk_bf16(float lo, float hi) { unsigned r; asm volatile("v_cvt_pk_bf16_f32 %0, %1, %2" : "=v"(r) : "v"(lo), "v"(hi)); return r; }
__device__ __forceinline__ unsigned pk_bf16(float lo, float hi) { typedef float f2 __attribute__((ext_vector_type(2))); typedef __bf16 b2 __attribute__((ext_vector_type(2))); f2 v = {lo, hi}; b2 b = __builtin_convertvector(v, b2); return __builtin_bit_cast(unsigned, b); }
__device__ __forceinline__ float sigmoidf_(float x) { return __builtin_amdgcn_rcpf(1.0f + __builtin_amdgcn_exp2f(-1.4426950408889634f * x)); }
constexpr int LDU_ = 5632, NG_ = 8192;
struct EpiIn {
    static constexpr bool PERM = true, AFTER_DRAIN = false;
    bf16_t* U; bf16_t* G; const float* bgate; unsigned* kc2max; float c2;
    __device__ __forceinline__ void operator()(const f32x4 (&acc)[2][2][4][2], const Unit& u, int wr, int wc, int fr, int fq) const {
        const int row0 = u.pm * BM + wr * 64 + fr;
        if (u.pn < 22) {
            const bool isq = (u.pn < 2) || (u.pn == 10) || (u.pn == 11) || (u.pn == 16) || (u.pn == 17);
            const float sc = isq ? c2 : 1.0f;
            const int col0 = u.pn * BM + wc * 32 + 8 * fq;
#pragma unroll
            for (int ai = 0; ai < 2; ++ai)
#pragma unroll
                for (int m = 0; m < 4; ++m) { bf16_t* rowp = U + (size_t)(row0 + ai * HALF + m * 16) * LDU_ + col0;
#pragma unroll
                    for (int bj = 0; bj < 2; ++bj) { const f32x4 v0 = acc[ai][bj][m][0] * sc, v1 = acc[ai][bj][m][1] * sc; u32x4 w;
                        w.x = pk_bf16(v0[0], v0[1]); w.y = pk_bf16(v0[2], v0[3]); w.z = pk_bf16(v1[0], v1[1]); w.w = pk_bf16(v1[2], v1[3]); *(u32x4*)(rowp + bj * HALF) = w; } }
            if (u.pn == 2 || u.pn == 3) {
#pragma unroll
                for (int bj = 0; bj < 2; ++bj) { float mx = 0.f;
#pragma unroll
                    for (int ai = 0; ai < 2; ++ai)
#pragma unroll
                        for (int m = 0; m < 4; ++m) { const f32x4 a = acc[ai][bj][m][0], b = acc[ai][bj][m][1];
                            float s = (a[0] * a[0] + a[1] * a[1]) + (a[2] * a[2] + a[3] * a[3]) + (b[0] * b[0] + b[1] * b[1]) + (b[2] * b[2] + b[3] * b[3]);
                            s += __shfl_xor(s, 16); s += __shfl_xor(s, 32); mx = fmaxf(mx, s); }
                    mx = fmaxf(mx, __shfl_xor(mx, 1)); mx = fmaxf(mx, __shfl_xor(mx, 2)); mx = fmaxf(mx, __shfl_xor(mx, 4)); mx = fmaxf(mx, __shfl_xor(mx, 8));
                    if (fr == 0 && fq == 0) atomicMax(kc2max + ((u.pn - 2) * 2 + bj) * 4 + wc, __float_as_uint(mx)); }
            }
        } else {
            const int gcol0 = (u.pn - 22) * BM + wc * 32 + 8 * fq;
#pragma unroll
            for (int bj = 0; bj < 2; ++bj) { const f32x4 b0 = *(const f32x4*)(bgate + gcol0 + bj * HALF), b1 = *(const f32x4*)(bgate + gcol0 + bj * HALF + 4);
#pragma unroll
                for (int ai = 0; ai < 2; ++ai)
#pragma unroll
                    for (int m = 0; m < 4; ++m) { const f32x4 v0 = acc[ai][bj][m][0] + b0, v1 = acc[ai][bj][m][1] + b1; u32x4 w;
                        w.x = pk_bf16(sigmoidf_(v0[0]), sigmoidf_(v0[1])); w.y = pk_bf16(sigmoidf_(v0[2]), sigmoidf_(v0[3]));
                        w.z = pk_bf16(sigmoidf_(v1[0]), sigmoidf_(v1[1])); w.w = pk_bf16(sigmoidf_(v1[2]), sigmoidf_(v1[3]));
                        *(u32x4*)(G + (size_t)(row0 + ai * HALF + m * 16) * NG_ + gcol0 + bj * HALF) = w; } }
        }
    }
};
struct EpiBranch {
    static constexpr bool PERM = true, AFTER_DRAIN = false;
    const bf16_t* G; float* MF; bf16_t* MB;
    __device__ __forceinline__ void operator()(const f32x4 (&acc)[2][2][4][2], const Unit& u, int wr, int wc, int fr, int fq) const {
        const int g = u.pm >> 5, pmr = u.pm & 31, pnr = u.pn & 7;
        const int row0 = pmr * BM + wr * 64 + fr, col0 = pnr * BM + wc * 32 + 8 * fq;
#pragma unroll
        for (int ai = 0; ai < 2; ++ai)
#pragma unroll
            for (int m = 0; m < 4; ++m) { const size_t row = (size_t)(row0 + ai * HALF + m * 16);
#pragma unroll
                for (int bj = 0; bj < 2; ++bj) { const int col = col0 + bj * HALF;
                    const u32x4 gw = *(const u32x4*)(G + row * NG_ + g * 2048 + col);
                    f32x4 g0, g1; g0[0] = __uint_as_float(gw.x << 16); g0[1] = __uint_as_float(gw.x & 0xffff0000u); g0[2] = __uint_as_float(gw.y << 16); g0[3] = __uint_as_float(gw.y & 0xffff0000u);
                    g1[0] = __uint_as_float(gw.z << 16); g1[1] = __uint_as_float(gw.z & 0xffff0000u); g1[2] = __uint_as_float(gw.w << 16); g1[3] = __uint_as_float(gw.w & 0xffff0000u);
                    f32x4 v0 = acc[ai][bj][m][0] * g0, v1 = acc[ai][bj][m][1] * g1;
                    float* mf = MF + row * 2048 + col;
                    if (g > 0) { v0 += *(const f32x4*)mf; v1 += *(const f32x4*)(mf + 4); }
                    if (g < 3) { *(f32x4*)mf = v0; *(f32x4*)(mf + 4) = v1; }
                    else { u32x4 w; w.x = pk_bf16(v0[0], v0[1]); w.y = pk_bf16(v0[2], v0[3]); w.z = pk_bf16(v1[0], v1[1]); w.w = pk_bf16(v1[2], v1[3]); *(u32x4*)(MB + row * 2048 + col) = w; } } }
    }
};
struct BranchOrder {
    int G, c;
    __device__ bool next(int i, Unit& u) const { const int tile = (i >> 2) * G + c; if (tile >= 256) return false; const int g = i & 3; u.pm = g * 32 + (tile >> 3); u.pn = g * 8 + (tile & 7); return true; }
    __device__ __forceinline__ void a_ready(const Unit&) const {}
    __device__ __forceinline__ void done(const Unit&) const {}
};
struct EpiResid {
    static constexpr bool PERM = false, AFTER_DRAIN = false;
    const float* X; float* Y; float alpha;
    __device__ __forceinline__ void operator()(const f32x4 (&acc)[2][2][4][2], const Unit& u, int wr, int wc, int fr, int fq) const {
        const int row0 = u.pm * BM + wr * 64 + fr, col0 = u.pn * BM + wc * 32 + 4 * fq;
#pragma unroll
        for (int ai = 0; ai < 2; ++ai)
#pragma unroll
            for (int m = 0; m < 4; ++m) { const size_t off = (size_t)(row0 + ai * HALF + m * 16) * 2048 + col0;
#pragma unroll
                for (int bj = 0; bj < 2; ++bj)
#pragma unroll
                    for (int n = 0; n < 2; ++n) { const f32x4 x = *(const f32x4*)(X + off + bj * HALF + n * 16); *(f32x4*)(Y + off + bj * HALF + n * 16) = x * alpha + acc[ai][bj][m][n]; } }
    }
};
struct EpiRelu2 {
    static constexpr bool PERM = true, AFTER_DRAIN = false;
    bf16_t* H;
    __device__ __forceinline__ void operator()(const f32x4 (&acc)[2][2][4][2], const Unit& u, int wr, int wc, int fr, int fq) const {
        const int row0 = u.pm * BM + wr * 64 + fr, col0 = u.pn * BM + wc * 32 + 8 * fq;
#pragma unroll
        for (int ai = 0; ai < 2; ++ai)
#pragma unroll
            for (int m = 0; m < 4; ++m) { bf16_t* rowp = H + (size_t)(row0 + ai * HALF + m * 16) * 8192 + col0;
#pragma unroll
                for (int bj = 0; bj < 2; ++bj) { f32x4 v0 = acc[ai][bj][m][0], v1 = acc[ai][bj][m][1];
#pragma unroll
                    for (int e = 0; e < 4; ++e) { const float a = fmaxf(v0[e], 0.f), b = fmaxf(v1[e], 0.f); v0[e] = a * a; v1[e] = b * b; }
                    u32x4 w; w.x = pk_bf16(v0[0], v0[1]); w.y = pk_bf16(v0[2], v0[3]); w.z = pk_bf16(v1[0], v1[1]); w.w = pk_bf16(v1[2], v1[3]); *(u32x4*)(rowp + bj * HALF) = w; } }
    }
};

template <class Epi, class Sched, bool ALIGN_EPI = false, bool SP2 = false>
__device__ __forceinline__ void gemm_phase(PG8_LAS unsigned char* lds, const Gemm g, const Sched& S, const Epi& E) {
    const int tid = tid_fresh(), wid = __builtin_amdgcn_readfirstlane(tid >> 6), lane = tid & 63, wr = wid >> 2, wc = wid & 3, fr = lane & 15, fq = lane >> 4;
    const int K = g.K, nt = K / BK;
    unsigned voffA[2], voffB[2];
#pragma unroll
    for (int i = 0; i < 2; ++i) { int R, C; stage_rc(tid * 16 + i * 8192, R, C); const int Rb = Epi::PERM ? ((R & ~31) + perm32(R & 31)) : R;
        voffA[i] = (unsigned)(R * K + C) * 2u; voffB[i] = (unsigned)(Rb * K + C) * 2u; }
    const size_t kstep = (size_t)(BK * 2);
    const size_t hstep = (size_t)HALF * K * 2;
    const size_t tstep = 2 * hstep;
    const unsigned ldsw = (unsigned)wid * 1024u;
    const int aoff = lds_byte(wr * 64 + fr, fq * 8), boff = lds_byte(wc * 32 + fr, fq * 8);
#define PG8_SA(b, h) (((b) * 2 + (h)) * HTB)
#define PG8_SB(b, h) ((4 + (b) * 2 + (h)) * HTB)
#define PG8_STAGE(bufoff, gbase, voff) do { _Pragma("unroll") for (int _i = 0; _i < 2; ++_i) \
        __builtin_amdgcn_global_load_lds((const unsigned*)((const char*)(gbase) + (voff)[_i]), (PG8_LAS unsigned*)(lds + (bufoff) + ldsw + _i * 8192), 16, 0, 0); } while (0)
#define PG8_LDA(dst, b, h) do { _Pragma("unroll") for (int m = 0; m < 4; ++m) _Pragma("unroll") for (int k = 0; k < 2; ++k) dst[m][k] = *(const PG8_LAS bf16x8*)(lds + PG8_SA(b, h) + aoff + m * 2048 + k * 1024); } while (0)
#define PG8_LDB(dst, b, h) do { _Pragma("unroll") for (int n = 0; n < 2; ++n) _Pragma("unroll") for (int k = 0; k < 2; ++k) dst[n][k] = *(const PG8_LAS bf16x8*)(lds + PG8_SB(b, h) + boff + n * 2048 + k * 1024); } while (0)
#define PG8_MMA(ai, bj, At, Bt) do { __builtin_amdgcn_s_setprio(1); _Pragma("unroll") for (int m = 0; m < 4; ++m) _Pragma("unroll") for (int n = 0; n < 2; ++n) _Pragma("unroll") for (int k = 0; k < 2; ++k) \
        acc[ai][bj][m][n] = __builtin_amdgcn_mfma_f32_16x16x32_bf16(Bt[n][k], At[m][k], acc[ai][bj][m][n], 0, 0, 0); __builtin_amdgcn_s_setprio(0); } while (0)
#define PG8_WAIT_V(n) asm volatile("s_waitcnt vmcnt(" #n ")" ::: "memory")
#define PG8_WAIT_L(n) asm volatile("s_waitcnt lgkmcnt(" #n ")" ::: "memory")
#define PG8_BAR __builtin_amdgcn_s_barrier()
#define PG8_SCHED __builtin_amdgcn_sched_barrier(0)
    Unit cur, nxt; int ui = 0;
    if (!S.next(0, cur)) return;
    f32x4 acc[2][2][4][2];
#pragma unroll
    for (int a = 0; a < 2; ++a)
#pragma unroll
        for (int b = 0; b < 2; ++b)
#pragma unroll
            for (int m = 0; m < 4; ++m)
#pragma unroll
                for (int n = 0; n < 2; ++n) acc[a][b][m][n] = (f32x4){0.f, 0.f, 0.f, 0.f};
    bf16x8 At[4][2], B0[2][2], B1[2][2];
    const char* cA = (const char*)g.A + (size_t)cur.pm * tstep; const char* cB = (const char*)g.Bt + (size_t)cur.pn * tstep;
    S.a_ready(cur);
    if constexpr (SP2) {
        PG8_STAGE(PG8_SB(0, 0), cB, voffB); PG8_STAGE(PG8_SB(0, 1), cB + hstep, voffB); PG8_STAGE(PG8_SA(0, 0), cA, voffA); PG8_STAGE(PG8_SA(0, 1), cA + hstep, voffA);
        if (wr == 1) PG8_BAR;
        PG8_WAIT_V(2); PG8_BAR;
        PG8_STAGE(PG8_SB(1, 0), cB + kstep, voffB); PG8_STAGE(PG8_SA(1, 0), cA + kstep, voffA); PG8_STAGE(PG8_SB(1, 1), cB + hstep + kstep, voffB);
        PG8_WAIT_V(6); PG8_BAR;
    } else {
        PG8_STAGE(PG8_SB(0, 0), cB, voffB); PG8_STAGE(PG8_SA(0, 0), cA, voffA); PG8_STAGE(PG8_SB(0, 1), cB + hstep, voffB); PG8_STAGE(PG8_SA(0, 1), cA + hstep, voffA);
        if (wr == 1) PG8_BAR;
        PG8_WAIT_V(4); PG8_BAR;
        PG8_STAGE(PG8_SB(1, 0), cB + kstep, voffB); PG8_STAGE(PG8_SA(1, 0), cA + kstep, voffA); PG8_STAGE(PG8_SB(1, 1), cB + hstep + kstep, voffB);
        PG8_WAIT_V(6); PG8_BAR;
    }
    for (;;) {
        const bool has_next = S.next(ui + 1, nxt);
        const char* nA = has_next ? (const char*)g.A + (size_t)nxt.pm * tstep : cA; const char* nB = has_next ? (const char*)g.Bt + (size_t)nxt.pn * tstep : cB;
        for (int t = 0; t < nt; t += 2) {
            const bool last = (t == nt - 2);
            const char* a1 = cA + (size_t)(t + 1) * kstep;
            const char* a2 = last ? nA : cA + (size_t)(t + 2) * kstep; const char* b2 = last ? nB : cB + (size_t)(t + 2) * kstep;
            const char* a3 = a2 + kstep; const char* b3 = b2 + kstep;
            if (last && has_next) S.a_ready(nxt);
            if constexpr (SP2) {
            PG8_LDB(B0, 0, 0); PG8_LDB(B1, 0, 1); PG8_SCHED; PG8_LDA(At, 0, 0); PG8_STAGE(PG8_SA(1, 1), a1 + hstep, voffA);
            PG8_WAIT_V(8); PG8_WAIT_L(0); PG8_BAR; PG8_MMA(0, 0, At, B0); PG8_MMA(0, 1, At, B1); PG8_BAR; PG8_SCHED;
            PG8_LDA(At, 0, 1); PG8_STAGE(PG8_SB(0, 0), b2, voffB); PG8_STAGE(PG8_SB(0, 1), b2 + hstep, voffB); PG8_STAGE(PG8_SA(0, 0), a2, voffA);
            PG8_WAIT_V(8); PG8_WAIT_L(0); PG8_BAR; PG8_MMA(1, 0, At, B0); PG8_MMA(1, 1, At, B1); PG8_BAR; PG8_SCHED;
            PG8_LDB(B0, 1, 0); PG8_LDB(B1, 1, 1); PG8_SCHED; PG8_LDA(At, 1, 0); PG8_STAGE(PG8_SA(0, 1), a2 + hstep, voffA);
            PG8_WAIT_V(8); PG8_WAIT_L(0); PG8_BAR; PG8_MMA(0, 0, At, B0); PG8_MMA(0, 1, At, B1); PG8_BAR; PG8_SCHED;
            PG8_LDA(At, 1, 1); PG8_STAGE(PG8_SB(1, 0), b3, voffB); PG8_STAGE(PG8_SB(1, 1), b3 + hstep, voffB); PG8_STAGE(PG8_SA(1, 0), a3, voffA);
            PG8_WAIT_V(8); PG8_WAIT_L(0); PG8_BAR; PG8_MMA(1, 0, At, B0); PG8_MMA(1, 1, At, B1); PG8_BAR; PG8_SCHED;
            } else {
            PG8_LDB(B0, 0, 0); PG8_SCHED; PG8_LDA(At, 0, 0); PG8_STAGE(PG8_SA(1, 1), a1 + hstep, voffA);
            PG8_WAIT_L(8); PG8_BAR; PG8_WAIT_L(0); PG8_MMA(0, 0, At, B0); PG8_BAR; PG8_SCHED;
            PG8_LDB(B1, 0, 1); PG8_STAGE(PG8_SB(0, 0), b2, voffB);
            PG8_BAR; PG8_WAIT_L(0); PG8_MMA(0, 1, At, B1); PG8_BAR;
            PG8_LDA(At, 0, 1); PG8_STAGE(PG8_SA(0, 0), a2, voffA);
            PG8_BAR; PG8_WAIT_L(0); PG8_MMA(1, 0, At, B0); PG8_BAR; PG8_SCHED;
            PG8_STAGE(PG8_SB(0, 1), b2 + hstep, voffB);
            PG8_WAIT_V(6); PG8_BAR; PG8_MMA(1, 1, At, B1); PG8_BAR;
            PG8_LDB(B0, 1, 0); PG8_SCHED; PG8_LDA(At, 1, 0); PG8_STAGE(PG8_SA(0, 1), a2 + hstep, voffA);
            PG8_WAIT_L(8); PG8_BAR; PG8_WAIT_L(0); PG8_MMA(0, 0, At, B0); PG8_BAR; PG8_SCHED;
            PG8_LDB(B1, 1, 1); PG8_STAGE(PG8_SB(1, 0), b3, voffB);
            PG8_BAR; PG8_WAIT_L(0); PG8_MMA(0, 1, At, B1); PG8_BAR;
            PG8_LDA(At, 1, 1); PG8_STAGE(PG8_SA(1, 0), a3, voffA);
            PG8_BAR; PG8_WAIT_L(0); PG8_MMA(1, 0, At, B0); PG8_BAR; PG8_SCHED;
            PG8_STAGE(PG8_SB(1, 1), b3 + hstep, voffB);
            PG8_WAIT_V(6); PG8_BAR; PG8_MMA(1, 1, At, B1); PG8_BAR;
            }
        }
        if constexpr (ALIGN_EPI) { if (wr == 0) PG8_BAR; }
        if constexpr (!Epi::AFTER_DRAIN) { E(acc, cur, wr, wc, fr, fq); S.done(cur); }
        if (!has_next) break;
#pragma unroll
        for (int a = 0; a < 2; ++a)
#pragma unroll
            for (int b = 0; b < 2; ++b)
#pragma unroll
                for (int m = 0; m < 4; ++m)
#pragma unroll
                    for (int n = 0; n < 2; ++n) acc[a][b][m][n] = (f32x4){0.f, 0.f, 0.f, 0.f};
        cur = nxt; cA = nA; cB = nB; ++ui;
        if constexpr (ALIGN_EPI) { if (wr == 1) PG8_BAR; }
    }
    PG8_WAIT_V(0);
    if constexpr (!ALIGN_EPI) { if (wr == 0) PG8_BAR; }
    PG8_BAR;
    if constexpr (Epi::AFTER_DRAIN) { E.fused(acc, cur, wr, wc, fr, fq, lds, wid, lane); S.done(cur); }
#undef PG8_SA
#undef PG8_SB
#undef PG8_STAGE
#undef PG8_LDA
#undef PG8_LDB
#undef PG8_MMA
#undef PG8_WAIT_V
#undef PG8_WAIT_L
#undef PG8_BAR
#undef PG8_SCHED
}
}
namespace mk {
using pg8::bf16_t; using pg8::bf16x8; using pg8::f32x4; using pg8::u32x4;
#define LAS __attribute__((address_space(3)))
typedef float f32x16 __attribute__((ext_vector_type(16)));
typedef short s16x4 __attribute__((ext_vector_type(4)));
typedef unsigned u32x2 __attribute__((ext_vector_type(2)));
constexpr int SEQ = 8192, DM = 2048, DIN = 5636, LDU = 5632, NBIG = 13824, DFF = 8192, WBR = 512, NH = 4, HD = 128;
constexpr float LOG2E = 1.4426950408889634f;
constexpr float C2 = 0.08838834764831845f * LOG2E;
constexpr float ALPHA = 1.4142135623730951f;
constexpr float LN_EPS = 1e-5f;
constexpr size_t MiB = 1u << 20;
constexpr size_t WS_CTL = 0, WS_WIN = 1 * MiB, WS_WB = 55 * MiB, WS_WO = 63 * MiB, WS_W1 = 71 * MiB, WS_W2 = 103 * MiB, WS_U = 135 * MiB, WS_GH = 223 * MiB,
                 WS_OALL = 351 * MiB, WS_MFY = 383 * MiB, WS_MB = 447 * MiB, WS_XN = 479 * MiB, WS_LF = 511 * MiB, WS_F2 = 511 * MiB + 256 * 1024, WS_END = 512 * MiB;
constexpr int LDS_BYTES = 147456;
constexpr int NUNITS_MIX = 16 + 3 * 128;

__device__ __forceinline__ unsigned f2bf(float f) { unsigned u = __builtin_bit_cast(unsigned, f); return (u + 0x7fffu + ((u >> 16) & 1u)) >> 16; }
__device__ __forceinline__ unsigned pk2(float lo, float hi) { return f2bf(lo) | (f2bf(hi) << 16); }
__device__ __forceinline__ float bf2f(unsigned short h) { return __uint_as_float((unsigned)h << 16); }
__device__ __forceinline__ float wave_sum(float v) {
#pragma unroll
    for (int o = 1; o < 64; o <<= 1) v += __shfl_xor(v, o);
    return v;
}
__device__ __forceinline__ float log_sigmoid(float x) { return fminf(x, 0.f) - log1pf(expf(-fabsf(x))); }

__device__ __forceinline__ void transpose_item(const float* __restrict__ W, int ldw, int col0, int k0, bf16_t* __restrict__ WT, int K, int row0, LAS float* scr, int lane) {
#pragma unroll 8
    for (int i = 0; i < 32; ++i) { const int kk = 2 * i + (lane >> 5); scr[kk * 33 + (lane & 31)] = W[(size_t)(k0 + kk) * ldw + col0 + (lane & 31)]; }
    asm volatile("s_waitcnt lgkmcnt(0)" ::: "memory");
    const int c = lane & 7;
#pragma unroll
    for (int j = 0; j < 4; ++j) { const int n = (lane >> 3) + 8 * j; const LAS float* s = scr + (8 * c) * 33 + n;
        u32x4 o; o.x = pk2(s[0 * 33], s[1 * 33]); o.y = pk2(s[2 * 33], s[3 * 33]); o.z = pk2(s[4 * 33], s[5 * 33]); o.w = pk2(s[6 * 33], s[7 * 33]);
        *(u32x4*)(WT + (size_t)(row0 + n) * K + k0 + 8 * c) = o; }
    asm volatile("s_waitcnt lgkmcnt(0)" ::: "memory");
}
struct Ptrs {
    const float *x, *ln_in_g, *ln_in_b, *w_in, *b_forget, *conv_w, *conv_b, *w_r, *b_r, *w_i, *b_i, *lam, *rel_bias, *w_branch, *w_gate, *b_gate, *w_out, *ln1_g, *ln1_b, *w_ff1, *w_ff2, *ln2_g, *ln2_b;
    float* out; unsigned char* ws;
};
struct Args { const float* in[23]; float* out; unsigned char* ws; };
typedef const Args __attribute__((address_space(4))) * KArgP;
__device__ __forceinline__ KArgP kargs() { KArgP p = (KArgP)__builtin_amdgcn_kernarg_segment_ptr(); asm volatile("" : "+s"(p)); return p; }
__device__ __forceinline__ void convert_weights(const Ptrs& P, int l, LAS unsigned char* lds, int gw, int ngw, int wave, int lane) {
    LAS float* scr = (LAS float*)(lds + wave * 16384);
    bf16_t* WIN = (bf16_t*)(P.ws + WS_WIN); bf16_t* WB = (bf16_t*)(P.ws + WS_WB); bf16_t* WO = (bf16_t*)(P.ws + WS_WO); bf16_t* W1 = (bf16_t*)(P.ws + WS_W1); bf16_t* W2 = (bf16_t*)(P.ws + WS_W2);
    constexpr int I_IN = 32 * 176, I_G = 4 * 32 * 64, I_B = 4 * 8 * 64, I_O = 32 * 64, I_1 = 32 * 256, I_2 = 128 * 64, NIT = I_IN + I_G + I_B + I_O + I_1 + I_2;
    for (int it = gw; it < NIT; it += ngw) {
        int r = it;
        if (r < I_IN) { const int kb = r / 176, nb = r % 176, d = 32 * nb; transpose_item(P.w_in + (size_t)l * DM * DIN, DIN, d < 1536 ? d : d + 4, 64 * kb, WIN, DM, d, scr, lane); continue; } r -= I_IN;
        if (r < I_G) { const int g = r / 2048, q = r % 2048, kb = q / 64, nb = q % 64; transpose_item(P.w_gate + (size_t)(l * 4 + g) * DM * DM, DM, 32 * nb, 64 * kb, WIN, DM, LDU + g * 2048 + 32 * nb, scr, lane); continue; } r -= I_G;
        if (r < I_B) { const int g = r / 512, q = r % 512, kb = q / 64, nb = q % 64; transpose_item(P.w_branch + (size_t)(l * 4 + g) * WBR * DM, DM, 32 * nb, 64 * kb, WB + (size_t)g * DM * WBR, WBR, 32 * nb, scr, lane); continue; } r -= I_B;
        if (r < I_O) { const int kb = r / 64, nb = r % 64; transpose_item(P.w_out + (size_t)l * DM * DM, DM, 32 * nb, 64 * kb, WO, DM, 32 * nb, scr, lane); continue; } r -= I_O;
        if (r < I_1) { const int kb = r / 256, nb = r % 256; transpose_item(P.w_ff1 + (size_t)l * DM * DFF, DFF, 32 * nb, 64 * kb, W1, DM, 32 * nb, scr, lane); continue; } r -= I_1;
        { const int kb = r / 64, nb = r % 64; transpose_item(P.w_ff2 + (size_t)l * DFF * DM, DM, 32 * nb, 64 * kb, W2, DFF, 32 * nb, scr, lane); }
    }
}
__device__ __forceinline__ void ln_rows(const float* __restrict__ src, const float* __restrict__ g, const float* __restrict__ b, float* __restrict__ dx, bf16_t* __restrict__ dxn,
                                        const float* __restrict__ wf, const float* __restrict__ bfg, float* __restrict__ lf, int gw, int ngw, int lane) {
    for (int row = gw; row < SEQ; row += ngw) {
        const float* sr = src + (size_t)row * DM + 4 * lane;
        f32x4 v[8]; float s = 0.f;
#pragma unroll
        for (int j = 0; j < 8; ++j) { v[j] = *(const f32x4*)(sr + 256 * j); s += (v[j][0] + v[j][1]) + (v[j][2] + v[j][3]); }
        const float mean = wave_sum(s) * (1.f / DM); float s2 = 0.f;
#pragma unroll
        for (int j = 0; j < 8; ++j) { v[j] = v[j] - mean; s2 += (v[j][0] * v[j][0] + v[j][1] * v[j][1]) + (v[j][2] * v[j][2] + v[j][3] * v[j][3]); }
        const float rstd = 1.0f / sqrtf(wave_sum(s2) * (1.f / DM) + LN_EPS);
        f32x4 dacc = {0.f, 0.f, 0.f, 0.f};
#pragma unroll
        for (int j = 0; j < 8; ++j) { const int c = 4 * lane + 256 * j; const f32x4 gg = *(const f32x4*)(g + c), bb = *(const f32x4*)(b + c);
            const f32x4 y = v[j] * rstd * gg + bb; v[j] = y;
            *(f32x4*)(dx + (size_t)row * DM + c) = y;
            u32x2 o; o.x = pk2(y[0], y[1]); o.y = pk2(y[2], y[3]); *(u32x2*)(dxn + (size_t)row * DM + c) = o; }
        if (wf) {
#pragma unroll
            for (int j = 0; j < 8; ++j) { const float* wp = wf + (size_t)(4 * lane + 256 * j) * DIN;
                const f32x4 w0 = *(const f32x4*)(wp), w1 = *(const f32x4*)(wp + DIN), w2 = *(const f32x4*)(wp + 2 * DIN), w3 = *(const f32x4*)(wp + 3 * DIN);
                dacc += w0 * v[j][0]; dacc += w1 * v[j][1]; dacc += w2 * v[j][2]; dacc += w3 * v[j][3];
                asm volatile("" ::: "memory"); } }
        if (wf) { float d0 = wave_sum(dacc[0]), d1 = wave_sum(dacc[1]), d2 = wave_sum(dacc[2]), d3 = wave_sum(dacc[3]);
            if (lane == 0) { f32x4 o; o[0] = log_sigmoid(d0 + bfg[0]); o[1] = log_sigmoid(d1 + bfg[1]); o[2] = log_sigmoid(d2 + bfg[2]); o[3] = log_sigmoid(d3 + bfg[3]); *(f32x4*)(lf + (size_t)row * 4) = o; } }
    }
}
__device__ __forceinline__ void cumsum_f(const float* lf, float* F2, LAS unsigned char* lds, int tid) {
    LAS float* part = (LAS float*)lds;
    const int h = tid >> 7, seg = tid & 127, base = seg * 64;
    float s = 0.f;
    for (int i = 0; i < 64; ++i) s += lf[(size_t)(base + i) * 4 + h];
    part[h * 128 + seg] = s;
    __syncthreads();
    float run = 0.f;
    for (int j = 0; j < seg; ++j) run += part[h * 128 + j];
    for (int i = 0; i < 64; ++i) { run += lf[(size_t)(base + i) * 4 + h]; F2[(size_t)h * SEQ + base + i] = run * LOG2E; }
    __syncthreads();
}
constexpr int A_K = 0, A_V = 32768, A_F2K = 65536, A_BIAS = 66048, A_FLAGS = 67328, A_UNIT = 67456;
__device__ __forceinline__ int offb(int row, int ch) { return 256 * row + 16 * (ch ^ (((row & 3) << 2) | ((row >> 2) & 3))); }
__device__ __forceinline__ s16x4 vtr(LAS const unsigned char* p) { return __builtin_bit_cast(s16x4, __builtin_amdgcn_ds_read_tr16_b64_v4i16((LAS s16x4*)p)); }
#define MFMA32(a, b, c) __builtin_amdgcn_mfma_f32_32x32x16_bf16((a), (b), (c), 0, 0, 0)
template <int S> __device__ __forceinline__ bf16x8 pack8(const f32x16& x) {
    u32x4 p; p.x = pg8::pk_bf16(x[8 * S], x[8 * S + 1]); p.y = pg8::pk_bf16(x[8 * S + 2], x[8 * S + 3]); p.z = pg8::pk_bf16(x[8 * S + 4], x[8 * S + 5]); p.w = pg8::pk_bf16(x[8 * S + 6], x[8 * S + 7]);
    return __builtin_bit_cast(bf16x8, p);
}
constexpr float FOX_TH2 = 60.0f;
constexpr float SB_RMIN = 1e-20f;

template <int MODE  >
__device__ __forceinline__ void attn_unit(LAS unsigned char* lds, const bf16_t* __restrict__ Qp, const bf16_t* __restrict__ Kp, const bf16_t* __restrict__ Vp, bf16_t* __restrict__ Op,
                                          const int qb, const float* __restrict__ F2h, const float* __restrict__ relb, const float kbnd) {
    const int tid = tid_fresh(), lane = tid & 63, w = __builtin_amdgcn_readfirstlane(tid >> 6), r = lane & 31, hh = lane >> 5;
    const int twmin = qb * 256 + w * 32, twmax = twmin + 31, t = twmin + r;
    bf16x8 qf[8];
    { const bf16_t* qrow = Qp + (size_t)t * LDU + 8 * hh;
#pragma unroll
      for (int kk = 0; kk < 8; ++kk) qf[kk] = *(const bf16x8*)(qrow + 16 * kk); }
    f32x16 O[4];
#pragma unroll
    for (int d = 0; d < 4; ++d)
#pragma unroll
        for (int i = 0; i < 16; ++i) O[d][i] = 0.f;
    float m = -INFINITY, l = 0.f, R = 1.f, f2q = 0.f, qn = 0.f;
    if (MODE == 0) { f2q = F2h[t]; float s = 0.f;
#pragma unroll
        for (int kk = 0; kk < 8; ++kk)
#pragma unroll
            for (int j = 0; j < 8; ++j) { const float v = bf2f((unsigned short)qf[kk][j]); s += v * v; }
        s += __shfl_xor(s, 32); qn = sqrtf(s) * kbnd; }
    LAS float* biasL = (LAS float*)(lds + A_BIAS);
    LAS unsigned* flags = (LAS unsigned*)(lds + A_FLAGS);
    if (MODE == 2) { for (int i = tid; i < 320; i += 512) biasL[i] = relb[i] * LOG2E; }
    const int jhi = 4 * qb + 3, jlo = (MODE == 2) ? (4 * qb - 8 > 0 ? 4 * qb - 8 : 0) : 0;
    const int srow = tid >> 4, sch = tid & 15, soff0 = offb(srow, sch), soff1 = offb(srow + 32, sch);
    const bf16_t* kg = Kp + (size_t)srow * LDU + 8 * sch; const bf16_t* vg = Vp + (size_t)srow * LDU + 8 * sch;
    u32x4 kr0, kr1, vr0, vr1; float f2r = 0.f;
#define A_LOADT(jt) do { const size_t o_ = (size_t)(jt) * 64 * LDU; kr0 = *(const u32x4*)(kg + o_); kr1 = *(const u32x4*)(kg + o_ + 32 * LDU); vr0 = *(const u32x4*)(vg + o_); vr1 = *(const u32x4*)(vg + o_ + 32 * LDU); \
        if (MODE == 0 && tid < 64) f2r = F2h[(jt) * 64 + tid]; } while (0)
#define A_STORET(b) do { *(LAS u32x4*)(lds + A_K + (b) * 16384 + soff0) = kr0; *(LAS u32x4*)(lds + A_K + (b) * 16384 + soff1) = kr1; *(LAS u32x4*)(lds + A_V + (b) * 16384 + soff0) = vr0; *(LAS u32x4*)(lds + A_V + (b) * 16384 + soff1) = vr1; \
        if (MODE == 0 && tid < 64) ((LAS float*)(lds + A_F2K + (b) * 256))[tid] = f2r; } while (0)
    A_LOADT(jhi); A_STORET(0);
    __syncthreads();
    const int xk = ((r & 3) << 2) | ((r >> 2) & 3);
    const int li = lane & 15, tq = li >> 2, tp = li & 3, rh = (lane >> 4) & 1;
    int buf = 0, it = 0; bool wdone = false;
    for (int jt = jhi; jt >= jlo; --jt, ++it) {
        const bool more = jt > jlo;
        if (more) A_LOADT(jt - 1);
        const int kb = jt * 64;
        bool active;
        if (MODE == 0) active = (kb <= twmax) && !wdone;
        else if (MODE == 1) active = (kb < twmax) && !wdone;
        else { const int cw = 4 * qb + (w >> 1); active = (jt <= cw) && (jt >= cw - 8); }
        if (active) {
            LAS const unsigned char* Kb = lds + A_K + buf * 16384; LAS const unsigned char* Vb = lds + A_V + buf * 16384;
            f32x16 X[2];
#pragma unroll
            for (int i = 0; i < 16; ++i) { X[0][i] = 0.f; X[1][i] = 0.f; }
#pragma unroll
            for (int kk = 0; kk < 8; ++kk) { const int o = 256 * r + 16 * ((2 * kk + hh) ^ xk);
                const bf16x8 k0 = *(LAS const bf16x8*)(Kb + o), k1 = *(LAS const bf16x8*)(Kb + o + 8192);
                X[0] = MFMA32(k0, qf[kk], X[0]); X[1] = MFMA32(k1, qf[kk], X[1]); }
            if (MODE == 0 || MODE == 2) {
                float mx = -INFINITY;
                if (MODE == 0) { LAS const float* f2k = (LAS const float*)(lds + A_F2K + buf * 256); const bool needmask = (kb + 63 > twmin);
#pragma unroll
                    for (int b = 0; b < 2; ++b)
#pragma unroll
                        for (int g = 0; g < 4; ++g) { const f32x4 fk = *(LAS const f32x4*)(f2k + 32 * b + 8 * g + 4 * hh);
#pragma unroll
                            for (int c = 0; c < 4; ++c) { float s = X[b][4 * g + c] + (f2q - fk[c]); if (needmask && (kb + 32 * b + 8 * g + 4 * hh + c > t)) s = -INFINITY; X[b][4 * g + c] = s; mx = fmaxf(mx, s); } }
                } else {
#pragma unroll
                    for (int b = 0; b < 2; ++b)
#pragma unroll
                        for (int i = 0; i < 16; ++i) { const int key = kb + 32 * b + 8 * (i >> 2) + 4 * hh + (i & 3); int dist = t - key; dist = dist < -63 ? -63 : (dist > 256 ? 256 : dist);
                            const float s = X[b][i] + biasL[dist + 63]; X[b][i] = s; mx = fmaxf(mx, s); }
                }
                mx = fmaxf(mx, __shfl_xor(mx, 32));
                const float mnew = fmaxf(m, mx), msafe = (mnew == -INFINITY) ? 0.f : mnew;
                const float alpha = __builtin_amdgcn_exp2f(m - msafe);
                float ps = 0.f;
#pragma unroll
                for (int b = 0; b < 2; ++b)
#pragma unroll
                    for (int i = 0; i < 16; ++i) { const float p = __builtin_amdgcn_exp2f(X[b][i] - msafe); X[b][i] = p; ps += p; }
                l = l * alpha + ps; m = mnew;
                if (!__all(alpha == 1.0f)) {
#pragma unroll
                    for (int d = 0; d < 4; ++d)
#pragma unroll
                        for (int i = 0; i < 16; ++i) O[d][i] *= alpha; }
            } else {
                const bool needmask = (kb + 63 >= twmin);
                f32x16 OM[2];
#pragma unroll
                for (int b = 0; b < 2; ++b)
#pragma unroll
                    for (int i = 0; i < 16; ++i) { const float e = __builtin_amdgcn_exp2f(fminf(X[b][i], 115.0f)); float omb = __builtin_amdgcn_rcpf(1.0f + e); float beta = e * omb;
                        if (needmask && (kb + 32 * b + 8 * (i >> 2) + 4 * hh + (i & 3) >= t)) { omb = 1.0f; beta = 0.f; }
                        OM[b][i] = omb; X[b][i] = beta; }
                float Rr = R;
#pragma unroll
                for (int b = 1; b >= 0; --b)
#pragma unroll
                    for (int g = 3; g >= 0; --g) { const float G = (OM[b][4 * g] * OM[b][4 * g + 1]) * (OM[b][4 * g + 2] * OM[b][4 * g + 3]); const float Gp = __shfl_xor(G, 32);
                        const float E = hh ? Rr : Rr * Gp; Rr = Rr * (G * Gp);
                        const float w3 = E, w2 = w3 * OM[b][4 * g + 3], w1 = w2 * OM[b][4 * g + 2], w0 = w1 * OM[b][4 * g + 1];
                        X[b][4 * g + 3] *= w3; X[b][4 * g + 2] *= w2; X[b][4 * g + 1] *= w1; X[b][4 * g] *= w0; }
                R = Rr;
            }
            const bf16x8 p00 = pack8<0>(X[0]), p01 = pack8<1>(X[0]), p10 = pack8<0>(X[1]), p11 = pack8<1>(X[1]);
#pragma unroll
            for (int db = 0; db < 4; ++db) {
#pragma unroll
                for (int bs = 0; bs < 4; ++bs) {
                    s16x4 v[2];
#pragma unroll
                    for (int jj = 0; jj < 2; ++jj) { const int xr = (tq << 2) | (2 * jj + hh); const int ch = (4 * db + 2 * rh + (tp >> 1)) ^ xr;
                        v[jj] = vtr(Vb + 256 * (16 * bs + 8 * jj + 4 * hh + tq) + 16 * ch + 8 * (tp & 1)); }
                    bf16x8 vf; vf[0] = v[0][0]; vf[1] = v[0][1]; vf[2] = v[0][2]; vf[3] = v[0][3]; vf[4] = v[1][0]; vf[5] = v[1][1]; vf[6] = v[1][2]; vf[7] = v[1][3];
                    O[db] = MFMA32(vf, bs == 0 ? p00 : (bs == 1 ? p01 : (bs == 2 ? p10 : p11)), O[db]); } }
            if (MODE == 0) { const float fk0 = ((LAS const float*)(lds + A_F2K + buf * 256))[0]; wdone = __all((qn + f2q - fk0 - m) < -FOX_TH2); }
            if (MODE == 1) wdone = __all(R < SB_RMIN);
        }
        if (more) A_STORET(buf ^ 1);
        if (MODE != 2) { if (lane == 0) flags[(it & 1) * 8 + w] = wdone ? 1u : 0u; }
        __syncthreads();
        if (MODE != 2) { unsigned a = 1u;
#pragma unroll
            for (int i = 0; i < 8; ++i) a &= flags[(it & 1) * 8 + i];
            if (a) break; }
        buf ^= 1;
    }
#undef A_LOADT
#undef A_STORET
    float sc = 1.0f;
    if (MODE != 1) { const float lt = l + __shfl_xor(l, 32); sc = 1.0f / lt; }
    bf16_t* orow = Op + (size_t)t * WBR + 4 * hh;
#pragma unroll
    for (int db = 0; db < 4; ++db)
#pragma unroll
        for (int g = 0; g < 4; ++g) { u32x2 o; o.x = pg8::pk_bf16(O[db][4 * g] * sc, O[db][4 * g + 1] * sc); o.y = pg8::pk_bf16(O[db][4 * g + 2] * sc, O[db][4 * g + 3] * sc);
            *(u32x2*)(orow + 32 * db + 8 * g) = o; }
}
constexpr int L_WR = 0, L_WI = 8704, L_RAW = 17408, L_XC = 50944, L_A = 85760, L_INP = 102144, L_RY = 118528, L_AH = 126720, L_CARRY = 130816, L_PAR = 131072;
__device__ __forceinline__ float gelu_tanh(float y) { const float u = 0.7978845608028654f * (y + 0.044715f * y * y * y); const float th = 1.0f - 2.0f / (1.0f + __expf(2.0f * u)); return 0.5f * y * (1.0f + th); }
__device__ __forceinline__ void lru_unit(LAS unsigned char* lds, const int l, const int n, const int cs, const bf16_t* __restrict__ U, bf16_t* __restrict__ Oout) {
    const int tid = tid_fresh(), lane = tid & 63, w = __builtin_amdgcn_readfirstlane(tid >> 6);
    const int ch0 = n * 128, oc0 = ch0 + 32 * cs;
    LAS float* par = (LAS float*)(lds + L_PAR);
    LAS float* carry = (LAS float*)(lds + L_CARRY);
    {
        KArgP k = kargs(); Ptrs P; P.w_r = k->in[7]; P.b_r = k->in[8]; P.w_i = k->in[9]; P.b_i = k->in[10]; P.lam = k->in[11]; P.conv_w = k->in[5]; P.conv_b = k->in[6];
        const float* wr = P.w_r + (size_t)(l * 4 + n) * 128 * 128; const float* wi = P.w_i + (size_t)(l * 4 + n) * 128 * 128;
        for (int idx = tid; idx < 128 * 32; idx += 512) { const int c = idx >> 5, d = idx & 31;
            *(LAS unsigned short*)(lds + L_WR + d * 272 + 2 * c) = (unsigned short)f2bf(wr[c * 128 + 32 * cs + d]);
            *(LAS unsigned short*)(lds + L_WI + d * 272 + 2 * c) = (unsigned short)f2bf(wi[c * 128 + 32 * cs + d]); }
        if (tid < 32) { par[tid] = 8.0f * log_sigmoid(P.lam[l * 512 + oc0 + tid]); par[32 + tid] = P.b_r[l * 512 + oc0 + tid]; par[64 + tid] = P.b_i[l * 512 + oc0 + tid]; carry[tid] = 0.f; carry[32 + tid] = 0.f; }
        if (tid < 128) { par[96 + tid] = P.conv_b[l * 512 + ch0 + tid];
#pragma unroll
            for (int j = 0; j < 4; ++j) par[224 + j * 128 + tid] = P.conv_w[(size_t)(l * 4 + j) * 512 + ch0 + tid]; }
    }
    const bf16_t* rxg = U + 1536 + ch0; const bf16_t* ryg = U + 2048 + oc0;
    u32x4 raw[5], ryr;
#define L_LOADT(t0) do { _Pragma("unroll") for (int i = 0; i < 5; ++i) { const int cidx = tid + 512 * i; const int row = cidx >> 4, ch = cidx & 15; const int tt = (t0) - 3 + row; \
            raw[i] = (u32x4){0u, 0u, 0u, 0u}; if (row < 131 && tt >= 0) raw[i] = *(const u32x4*)(rxg + (size_t)tt * LDU + 8 * ch); } \
        ryr = *(const u32x4*)(ryg + (size_t)((t0) + (tid >> 2)) * LDU + 8 * (tid & 3)); } while (0)
    L_LOADT(0);
    for (int ti = 0; ti < 64; ++ti) {
        const int t0 = ti * 128;
#pragma unroll
        for (int i = 0; i < 5; ++i) { const int cidx = tid + 512 * i; if (cidx < 131 * 16) *(LAS u32x4*)(lds + L_RAW + cidx * 16) = raw[i]; }
        *(LAS u32x4*)(lds + L_RY + tid * 16) = ryr;
        __syncthreads();
        if (ti + 1 < 64) L_LOADT(t0 + 128);
        { const int tok = tid >> 2, qd = tid & 3;
#pragma unroll
          for (int v = 0; v < 4; ++v) { const int c0 = 32 * qd + 8 * v; float xc[8];
#pragma unroll
              for (int e = 0; e < 8; ++e) xc[e] = par[96 + c0 + e];
#pragma unroll
              for (int j = 0; j < 4; ++j) { const u32x4 rw = *(LAS const u32x4*)(lds + L_RAW + (tok + j) * 256 + 2 * c0);
                  const unsigned ww[4] = {rw.x, rw.y, rw.z, rw.w};
#pragma unroll
                  for (int e = 0; e < 4; ++e) { xc[2 * e] += __uint_as_float(ww[e] << 16) * par[224 + j * 128 + c0 + 2 * e]; xc[2 * e + 1] += __uint_as_float(ww[e] & 0xffff0000u) * par[224 + j * 128 + c0 + 2 * e + 1]; } }
              u32x4 o; o.x = pk2(xc[0], xc[1]); o.y = pk2(xc[2], xc[3]); o.z = pk2(xc[4], xc[5]); o.w = pk2(xc[6], xc[7]);
              *(LAS u32x4*)(lds + L_XC + tok * 272 + 2 * c0) = o; } }
        __syncthreads();
        { const int fr = lane & 15, fq = lane >> 4;
          f32x4 ar[2], ai[2];
#pragma unroll
          for (int ct = 0; ct < 2; ++ct) { ar[ct] = (f32x4){0.f, 0.f, 0.f, 0.f}; ai[ct] = (f32x4){0.f, 0.f, 0.f, 0.f}; }
#pragma unroll
          for (int kk = 0; kk < 4; ++kk) { const bf16x8 a = *(LAS const bf16x8*)(lds + L_XC + (16 * w + fr) * 272 + 2 * (32 * kk + 8 * fq));
#pragma unroll
              for (int ct = 0; ct < 2; ++ct) { const bf16x8 br_ = *(LAS const bf16x8*)(lds + L_WR + (16 * ct + fr) * 272 + 2 * (32 * kk + 8 * fq)); const bf16x8 bi_ = *(LAS const bf16x8*)(lds + L_WI + (16 * ct + fr) * 272 + 2 * (32 * kk + 8 * fq));
                  ar[ct] = __builtin_amdgcn_mfma_f32_16x16x32_bf16(a, br_, ar[ct], 0, 0, 0); ai[ct] = __builtin_amdgcn_mfma_f32_16x16x32_bf16(a, bi_, ai[ct], 0, 0, 0); } }
#pragma unroll
          for (int ct = 0; ct < 2; ++ct) { const int d = 16 * ct + fr, c = 32 * cs + d;
#pragma unroll
              for (int rg = 0; rg < 4; ++rg) { const int tt = 16 * w + 4 * fq + rg;
                  const float rgate = pg8::sigmoidf_(ar[ct][rg] + par[32 + d]), igate = pg8::sigmoidf_(ai[ct][rg] + par[64 + d]);
                  const float la = rgate * par[d]; const float a = __expf(la); const float mult = sqrtf(fmaxf(-expm1f(2.0f * la), 0.f));
                  float xcf = par[96 + c];
#pragma unroll
                  for (int j = 0; j < 4; ++j) xcf += bf2f(*(LAS const unsigned short*)(lds + L_RAW + (tt + j) * 256 + 2 * c)) * par[224 + j * 128 + c];
                  ((LAS float*)(lds + L_A))[tt * 32 + d] = a; ((LAS float*)(lds + L_INP))[tt * 32 + d] = mult * igate * xcf; } } }
        __syncthreads();
        { const int d = tid & 31, sub = tid >> 5;
          LAS const float* Aa = (LAS const float*)(lds + L_A) + (8 * sub) * 32 + d; LAS const float* Ii = (LAS const float*)(lds + L_INP) + (8 * sub) * 32 + d;
          float av[8], iv[8], A = 1.f, H = 0.f;
#pragma unroll
          for (int i = 0; i < 8; ++i) { av[i] = Aa[i * 32]; iv[i] = Ii[i * 32]; H = av[i] * H + iv[i]; A *= av[i]; }
          LAS float* AH = (LAS float*)(lds + L_AH);
          AH[(sub * 32 + d) * 2] = A; AH[(sub * 32 + d) * 2 + 1] = H;
          __syncthreads();
          float h = carry[(ti & 1) * 32 + d];
          for (int s = 0; s < sub; ++s) h = AH[(s * 32 + d) * 2] * h + AH[(s * 32 + d) * 2 + 1];
#pragma unroll
          for (int i = 0; i < 8; ++i) { h = av[i] * h + iv[i]; const int tt = 8 * sub + i;
              const float y = bf2f(*(LAS const unsigned short*)(lds + L_RY + tt * 64 + 2 * d));
              Oout[(size_t)(t0 + tt) * WBR + oc0 + d] = (unsigned short)f2bf(h * gelu_tanh(y)); }
          if (sub == 15) carry[((ti + 1) & 1) * 32 + d] = h; }
        __syncthreads();
    }
#undef L_LOADT
}
constexpr int LDS_UNIT = 147392;
__device__ __forceinline__ Ptrs make_ptrs(KArgP k) {
    Ptrs P;
    P.x = k->in[0]; P.ln_in_g = k->in[1]; P.ln_in_b = k->in[2]; P.w_in = k->in[3]; P.b_forget = k->in[4]; P.conv_w = k->in[5]; P.conv_b = k->in[6]; P.w_r = k->in[7]; P.b_r = k->in[8]; P.w_i = k->in[9]; P.b_i = k->in[10];
    P.lam = k->in[11]; P.rel_bias = k->in[12]; P.w_branch = k->in[13]; P.w_gate = k->in[14]; P.b_gate = k->in[15]; P.w_out = k->in[16]; P.ln1_g = k->in[17]; P.ln1_b = k->in[18]; P.w_ff1 = k->in[19]; P.w_ff2 = k->in[20];
    P.ln2_g = k->in[21]; P.ln2_b = k->in[22]; P.out = k->out; P.ws = k->ws;
    return P;
}
__global__ void __launch_bounds__(512, 2) fwd_megakernel(Args a_unused) {
    extern __shared__ __attribute__((aligned(16))) unsigned char lds_raw[];
    LAS unsigned char* lds = (LAS unsigned char*)lds_raw;
    cg::grid_group grid = cg::this_grid();
#define MK_IDS() const int tid = tid_fresh(), lane = tid & 63, wave = __builtin_amdgcn_readfirstlane(tid >> 6); const int G = gridDim.x, bx = blockIdx.x; \
    const int vcu = (G % 8 == 0) ? (bx % 8) * (G / 8) + bx / 8 : bx; const int gw = vcu * 8 + wave, ngw = G * 8; (void)lane; (void)gw; (void)ngw; (void)tid;
    { MK_IDS(); KArgP k = kargs(); const Ptrs P = make_ptrs(k);
      convert_weights(P, 0, lds, gw, ngw, wave, lane);
      ln_rows(P.x, P.ln_in_g, P.ln_in_b, P.out, (bf16_t*)(P.ws + WS_XN), P.w_in + 1536, P.b_forget, (float*)(P.ws + WS_LF), gw, ngw, lane); }
    grid.sync();
#pragma unroll 1
    for (int l = 0; l < 2; ++l) {
        { MK_IDS(); KArgP k = kargs(); unsigned char* ws = k->ws;
          if (bx == 0) cumsum_f((const float*)(ws + WS_LF), (float*)(ws + WS_F2), lds, tid);
          pg8::Gemm g{(const bf16_t*)(ws + WS_XN), (const bf16_t*)(ws + WS_WIN), SEQ, NBIG, DM}; pg8::StaticOrder S; S.init(SEQ, NBIG, G, bx);
          pg8::EpiIn E{(bf16_t*)(ws + WS_U), (bf16_t*)(ws + WS_GH), k->in[15] + (size_t)l * 4 * DM, (unsigned*)(ws + WS_CTL) + 16 + 16 * l, C2};
          pg8::gemm_phase<pg8::EpiIn, pg8::StaticOrder, true, true>(lds, g, S, E); }
        grid.sync();
        { MK_IDS(); KArgP k = kargs(); unsigned char* ws = k->ws; unsigned* ctl = (unsigned*)(ws + WS_CTL);
          const bf16_t* U = (const bf16_t*)(ws + WS_U); bf16_t* OALL = (bf16_t*)(ws + WS_OALL); const float* F2 = (const float*)(ws + WS_F2);
            for (;;) {
                if (tid == 0) *(LAS int*)(lds + LDS_UNIT) = (int)atomicAdd(ctl + l, 1u);
                __syncthreads();
                const int unit = __builtin_amdgcn_readfirstlane(*(LAS int*)(lds + LDS_UNIT));
                __syncthreads();
                if (unit >= NUNITS_MIX) break;
                if (unit < 16) { lru_unit(lds, l, unit >> 2, unit & 3, U, OALL + (size_t)1 * SEQ * WBR); }
                else if (unit < 144) { const int kq = unit - 16, qb = 31 - (kq >> 2), h = kq & 3;
                    float s = 0.f;
#pragma unroll
                    for (int c = 0; c < 4; ++c) s += __uint_as_float(__hip_atomic_load(ctl + 16 + 16 * l + h * 4 + c, __ATOMIC_RELAXED, __HIP_MEMORY_SCOPE_AGENT));
                    attn_unit<0>(lds, U + h * HD, U + 512 + h * HD, U + 1024 + h * HD, OALL + h * HD, qb, F2 + (size_t)h * SEQ, nullptr, sqrtf(s) * 1.02f); }
                else if (unit < 272) { const int kq = unit - 144, qb = kq >> 2, h = kq & 3;
                    attn_unit<2>(lds, U + 4096 + h * HD, U + 4608 + h * HD, U + 5120 + h * HD, OALL + (size_t)3 * SEQ * WBR + h * HD, qb, nullptr, kargs()->in[12] + (size_t)(l * 4 + h) * 320, 0.f); }
                else { const int kq = unit - 272, qb = kq >> 2, h = kq & 3;
                    attn_unit<1>(lds, U + 2560 + h * HD, U + 3072 + h * HD, U + 3584 + h * HD, OALL + (size_t)2 * SEQ * WBR + h * HD, qb, nullptr, nullptr, 0.f); }
            }
        }
        grid.sync();
        { MK_IDS(); KArgP k = kargs(); unsigned char* ws = k->ws;
          pg8::Gemm g{(const bf16_t*)(ws + WS_OALL), (const bf16_t*)(ws + WS_WB), SEQ, DM, WBR}; pg8::BranchOrder S{G, bx};
          pg8::EpiBranch E{(const bf16_t*)(ws + WS_GH), (float*)(ws + WS_MFY), (bf16_t*)(ws + WS_MB)};
          pg8::gemm_phase<pg8::EpiBranch, pg8::BranchOrder, true, true>(lds, g, S, E); }
        grid.sync();
        { MK_IDS(); KArgP k = kargs(); unsigned char* ws = k->ws;
          pg8::Gemm g{(const bf16_t*)(ws + WS_MB), (const bf16_t*)(ws + WS_WO), SEQ, DM, DM}; pg8::StaticOrder S; S.init(SEQ, DM, G, bx);
          pg8::EpiResid E{k->out, (float*)(ws + WS_MFY), ALPHA};
          pg8::gemm_phase<pg8::EpiResid, pg8::StaticOrder, true, true>(lds, g, S, E); }
        grid.sync();
        { MK_IDS(); KArgP k = kargs(); unsigned char* ws = k->ws;
          ln_rows((const float*)(ws + WS_MFY), k->in[17] + (size_t)l * DM, k->in[18] + (size_t)l * DM, k->out, (bf16_t*)(ws + WS_XN), nullptr, nullptr, nullptr, gw, ngw, lane); }
        grid.sync();
        { MK_IDS(); KArgP k = kargs(); unsigned char* ws = k->ws;
          pg8::Gemm g{(const bf16_t*)(ws + WS_XN), (const bf16_t*)(ws + WS_W1), SEQ, DFF, DM}; pg8::StaticOrder S; S.init(SEQ, DFF, G, bx);
          pg8::EpiRelu2 E{(bf16_t*)(ws + WS_GH)};
          pg8::gemm_phase<pg8::EpiRelu2, pg8::StaticOrder, true, true>(lds, g, S, E); }
        grid.sync();
        { MK_IDS(); KArgP k = kargs(); unsigned char* ws = k->ws;
          pg8::Gemm g{(const bf16_t*)(ws + WS_GH), (const bf16_t*)(ws + WS_W2), SEQ, DM, DFF}; pg8::StaticOrder S; S.init(SEQ, DM, G, bx);
          pg8::EpiResid E{k->out, (float*)(ws + WS_MFY), ALPHA};
          pg8::gemm_phase<pg8::EpiResid, pg8::StaticOrder, true, true>(lds, g, S, E); }
        grid.sync();
        { MK_IDS(); KArgP k = kargs(); const Ptrs P = make_ptrs(k); unsigned char* ws = P.ws;
          if (l == 0) {
            ln_rows((const float*)(ws + WS_MFY), P.ln2_g, P.ln2_b, P.out, (bf16_t*)(ws + WS_XN), P.w_in + (size_t)DM * DIN + 1536, P.b_forget + 4, (float*)(ws + WS_LF), gw, ngw, lane);
            convert_weights(P, 1, lds, gw, ngw, wave, lane);
          } else {
            ln_rows((const float*)(ws + WS_MFY), P.ln2_g + DM, P.ln2_b + DM, P.out, (bf16_t*)(ws + WS_XN), nullptr, nullptr, nullptr, gw, ngw, lane);
          } }
        if (l == 0) grid.sync();
    }
}
}

extern "C" void kernel_launch(void* const* d_in, const int* in_sizes, int n_in, void* d_out, int out_size, void* d_ws, size_t ws_size, hipStream_t stream) {
    static int grid = 0;
    if (grid == 0) {
        if (n_in != 23 || out_size != mk::SEQ * mk::DM || ws_size < mk::WS_END) { fprintf(stderr, "kernel_launch: unexpected problem (n_in %d, out %d, ws %zu)\n", n_in, out_size, ws_size); grid = -1; return; }
        int dev = 0, cus = 0, per_cu = 0;
        hipGetDevice(&dev); hipDeviceGetAttribute(&cus, hipDeviceAttributeMultiprocessorCount, dev);
        if (hipFuncSetAttribute((const void*)mk::fwd_megakernel, hipFuncAttributeMaxDynamicSharedMemorySize, mk::LDS_BYTES) != hipSuccess) { fprintf(stderr, "kernel_launch: hipFuncSetAttribute failed\n"); grid = -1; return; }
        if (hipOccupancyMaxActiveBlocksPerMultiprocessor(&per_cu, (const void*)mk::fwd_megakernel, 512, mk::LDS_BYTES) != hipSuccess || per_cu < 1) { fprintf(stderr, "kernel_launch: occupancy query gave %d\n", per_cu); per_cu = 1; (void)hipGetLastError(); }
        grid = cus * per_cu;
    }
    if (grid < 0) return;
    hipMemsetAsync((char*)d_ws + mk::WS_CTL, 0, 4096, stream);
    mk::Args a{};
    for (int i = 0; i < 23; ++i) a.in[i] = (const float*)d_in[i];
    a.out = (float*)d_out; a.ws = (unsigned char*)d_ws;
    void* args[] = {&a};
    hipError_t e = hipLaunchCooperativeKernel((const void*)mk::fwd_megakernel, dim3(grid), dim3(512), args, mk::LDS_BYTES, stream);
    if (e != hipSuccess) fprintf(stderr, "cooperative launch failed: %s (grid %d)\n", hipGetErrorString(e), grid);
}
```

```cpp
#include <hip/hip_runtime.h>
#include <hip/hip_cooperative_groups.h>
#include <cstdio>
#include <cstdint>
namespace cg = cooperative_groups;
__device__ __forceinline__ int tid_fresh() { int t = threadIdx.x; asm volatile("" : "+v"(t)); return t; }
namespace pg8 {
#define PG8_LAS __attribute__((address_space(3)))
typedef unsigned short bf16_t;
typedef short bf16x8 __attribute__((ext_vector_type(8)));
typedef float f32x4 __attribute__((ext_vector_type(4)));
typedef unsigned u32x4 __attribute__((ext_vector_type(4)));
constexpr int BM = 256, BK = 64, HALF = 128, HTB = HALF * BK * 2  , STAGE_BYTES = 8 * HTB, NXCD = 8, WGM = 8;

__host__ __device__ __forceinline__ int lds_byte(int r, int c) { const int st = (r >> 4) * 2 + (c >> 5), rr = r & 15, cc = c & 31, ob = rr * 64 + cc * 2; return st * 1024 + (ob ^ (((ob >> 9) & 1) << 5)); }
__host__ __device__ __forceinline__ void stage_rc(int b, int& R, int& C) { const int st = b / 1024, sb = b % 1024, swz = sb ^ (((sb >> 9) & 1) << 5); R = (st >> 1) * 16 + swz / 64; C = (st & 1) * 32 + (swz % 64) / 2; }
__host__ __device__ __forceinline__ int perm32(int rho) { const int n = rho >> 4, i = rho & 15; return 8 * (i >> 2) + 4 * n + (i & 3); }

struct Unit { int pm, pn; };
struct Gemm { const bf16_t* A; const bf16_t* Bt; int M, N, K; };

struct StaticOrder {
    int nM, nN, nwg, G, c;
    __host__ __device__ void init(int M, int N, int G_, int c_) { nM = M / BM; nN = N / BM; nwg = nM * nN; G = G_; c = c_; }
    __host__ __device__ bool next(int i, Unit& u) const {
        const long L = (long)i * G + c; if (L >= nwg) return false;
        int wgid = (int)L; { const int q = nwg / NXCD, r = nwg % NXCD, xcd = wgid % NXCD, off = wgid / NXCD; wgid = (xcd < r ? xcd * (q + 1) : r * (q + 1) + (xcd - r) * q) + off; }
        const int nig = WGM * nN, gid = wgid / nig, fm = gid * WGM, gsz = (nM - fm) < WGM ? (nM - fm) : WGM;
        u.pm = fm + ((wgid % nig) % gsz); u.pn = (wgid % nig) / gsz; return true;
    }
    __device__ __forceinline__ void a_ready(const Unit&) const {}
    __device__ __forceinline__ void done(const Unit&) const {}
};

__device__ __forceinline__ unsigned cvt_pk_bf16(float lo, float hi) { unsigned r; asm volatile("v_cvt_pk_bf16_f32 %0, %1, %2" : "=v"(r) : "v"(lo), "v"(hi)); return r; }
__device__ __forceinline__ unsigned pk_bf16(float lo, float hi) { typedef float f2 __attribute__((ext_vector_type(2))); typedef __bf16 b2 __attribute__((ext_vector_type(2))); f2 v = {lo, hi}; b2 b = __builtin_convertvector(v, b2); return __builtin_bit_cast(unsigned, b); }
__device__ __forceinline__ float sigmoidf_(float x) { return __builtin_amdgcn_rcpf(1.0f + __builtin_amdgcn_exp2f(-1.4426950408889634f * x)); }
constexpr int LDU_ = 5632, NG_ = 8192;
struct EpiIn {
    static constexpr bool PERM = true, AFTER_DRAIN = false;
    bf16_t* U; bf16_t* G; const float* bgate; unsigned* kc2max; float c2;
    __device__ __forceinline__ void operator()(const f32x4 (&acc)[2][2][4][2], const Unit& u, int wr, int wc, int fr, int fq) const {
        const int row0 = u.pm * BM + wr * 64 + fr;
        if (u.pn < 22) {
            const bool isq = (u.pn < 2) || (u.pn == 10) || (u.pn == 11) || (u.pn == 16) || (u.pn == 17);
            const float sc = isq ? c2 : 1.0f;
            const int col0 = u.pn * BM + wc * 32 + 8 * fq;
#pragma unroll
            for (int ai = 0; ai < 2; ++ai)
#pragma unroll
                for (int m = 0; m < 4; ++m) { bf16_t* rowp = U + (size_t)(row0 + ai * HALF + m * 16) * LDU_ + col0;
#pragma unroll
                    for (int bj = 0; bj < 2; ++bj) { const f32x4 v0 = acc[ai][bj][m][0] * sc, v1 = acc[ai][bj][m][1] * sc; u32x4 w;
                        w.x = pk_bf16(v0[0], v0[1]); w.y = pk_bf16(v0[2], v0[3]); w.z = pk_bf16(v1[0], v1[1]); w.w = pk_bf16(v1[2], v1[3]); *(u32x4*)(rowp + bj * HALF) = w; } }
            if (u.pn == 2 || u.pn == 3) {
#pragma unroll
                for (int bj = 0; bj < 2; ++bj) { float mx = 0.f;
#pragma unroll
                    for (int ai = 0; ai < 2; ++ai)
#pragma unroll
                        for (int m = 0; m < 4; ++m) { const f32x4 a = acc[ai][bj][m][0], b = acc[ai][bj][m][1];
                            float s = (a[0] * a[0] + a[1] * a[1]) + (a[2] * a[2] + a[3] * a[3]) + (b[0] * b[0] + b[1] * b[1]) + (b[2] * b[2] + b[3] * b[3]);
                            s += __shfl_xor(s, 16); s += __shfl_xor(s, 32); mx = fmaxf(mx, s); }
                    mx = fmaxf(mx, __shfl_xor(mx, 1)); mx = fmaxf(mx, __shfl_xor(mx, 2)); mx = fmaxf(mx, __shfl_xor(mx, 4)); mx = fmaxf(mx, __shfl_xor(mx, 8));
                    if (fr == 0 && fq == 0) atomicMax(kc2max + ((u.pn - 2) * 2 + bj) * 4 + wc, __float_as_uint(mx)); }
            }
        } else {
            const int gcol0 = (u.pn - 22) * BM + wc * 32 + 8 * fq;
#pragma unroll
            for (int bj = 0; bj < 2; ++bj) { const f32x4 b0 = *(const f32x4*)(bgate + gcol0 + bj * HALF), b1 = *(const f32x4*)(bgate + gcol0 + bj * HALF + 4);
#pragma unroll
                for (int ai = 0; ai < 2; ++ai)
#pragma unroll
                    for (int m = 0; m < 4; ++m) { const f32x4 v0 = acc[ai][bj][m][0] + b0, v1 = acc[ai][bj][m][1] + b1; u32x4 w;
                        w.x = pk_bf16(sigmoidf_(v0[0]), sigmoidf_(v0[1])); w.y = pk_bf16(sigmoidf_(v0[2]), sigmoidf_(v0[3]));
                        w.z = pk_bf16(sigmoidf_(v1[0]), sigmoidf_(v1[1])); w.w = pk_bf16(sigmoidf_(v1[2]), sigmoidf_(v1[3]));
                        *(u32x4*)(G + (size_t)(row0 + ai * HALF + m * 16) * NG_ + gcol0 + bj * HALF) = w; } }
        }
    }
};
struct EpiBranch {
    static constexpr bool PERM = true, AFTER_DRAIN = false;
    const bf16_t* G; float* MF; bf16_t* MB;
    __device__ __forceinline__ void operator()(const f32x4 (&acc)[2][2][4][2], const Unit& u, int wr, int wc, int fr, int fq) const {
        const int g = u.pm >> 5, pmr = u.pm & 31, pnr = u.pn & 7;
        const int row0 = pmr * BM + wr * 64 + fr, col0 = pnr * BM + wc * 32 + 8 * fq;
#pragma unroll
        for (int ai = 0; ai < 2; ++ai)
#pragma unroll
            for (int m = 0; m < 4; ++m) { const size_t row = (size_t)(row0 + ai * HALF + m * 16);
#pragma unroll
                for (int bj = 0; bj < 2; ++bj) { const int col = col0 + bj * HALF;
                    const u32x4 gw = *(const u32x4*)(G + row * NG_ + g * 2048 + col);
                    f32x4 g0, g1; g0[0] = __uint_as_float(gw.x << 16); g0[1] = __uint_as_float(gw.x & 0xffff0000u); g0[2] = __uint_as_float(gw.y << 16); g0[3] = __uint_as_float(gw.y & 0xffff0000u);
                    g1[0] = __uint_as_float(gw.z << 16); g1[1] = __uint_as_float(gw.z & 0xffff0000u); g1[2] = __uint_as_float(gw.w << 16); g1[3] = __uint_as_float(gw.w & 0xffff0000u);
                    f32x4 v0 = acc[ai][bj][m][0] * g0, v1 = acc[ai][bj][m][1] * g1;
                    float* mf = MF + row * 2048 + col;
                    if (g > 0) { v0 += *(const f32x4*)mf; v1 += *(const f32x4*)(mf + 4); }
                    if (g < 3) { *(f32x4*)mf = v0; *(f32x4*)(mf + 4) = v1; }
                    else { u32x4 w; w.x = pk_bf16(v0[0], v0[1]); w.y = pk_bf16(v0[2], v0[3]); w.z = pk_bf16(v1[0], v1[1]); w.w = pk_bf16(v1[2], v1[3]); *(u32x4*)(MB + row * 2048 + col) = w; } } }
    }
};
struct BranchOrder {
    int G, c;
    __device__ bool next(int i, Unit& u) const { const int tile = (i >> 2) * G + c; if (tile >= 256) return false; const int g = i & 3; u.pm = g * 32 + (tile >> 3); u.pn = g * 8 + (tile & 7); return true; }
    __device__ __forceinline__ void a_ready(const Unit&) const {}
    __device__ __forceinline__ void done(const Unit&) const {}
};
struct EpiResid {
    static constexpr bool PERM = false, AFTER_DRAIN = false;
    const float* X; float* Y; float alpha;
    __device__ __forceinline__ void operator()(const f32x4 (&acc)[2][2][4][2], const Unit& u, int wr, int wc, int fr, int fq) const {
        const int row0 = u.pm * BM + wr * 64 + fr, col0 = u.pn * BM + wc * 32 + 4 * fq;
#pragma unroll
        for (int ai = 0; ai < 2; ++ai)
#pragma unroll
            for (int m = 0; m < 4; ++m) { const size_t off = (size_t)(row0 + ai * HALF + m * 16) * 2048 + col0;
#pragma unroll
                for (int bj = 0; bj < 2; ++bj)
#pragma unroll
                    for (int n = 0; n < 2; ++n) { const f32x4 x = *(const f32x4*)(X + off + bj * HALF + n * 16); *(f32x4*)(Y + off + bj * HALF + n * 16) = x * alpha + acc[ai][bj][m][n]; } }
    }
};
struct EpiRelu2 {
    static constexpr bool PERM = true, AFTER_DRAIN = false;
    bf16_t* H;
    __device__ __forceinline__ void operator()(const f32x4 (&acc)[2][2][4][2], const Unit& u, int wr, int wc, int fr, int fq) const {
        const int row0 = u.pm * BM + wr * 64 + fr, col0 = u.pn * BM + wc * 32 + 8 * fq;
#pragma unroll
        for (int ai = 0; ai < 2; ++ai)
#pragma unroll
            for (int m = 0; m < 4; ++m) { bf16_t* rowp = H + (size_t)(row0 + ai * HALF + m * 16) * 8192 + col0;
#pragma unroll
                for (int bj = 0; bj < 2; ++bj) { f32x4 v0 = acc[ai][bj][m][0], v1 = acc[ai][bj][m][1];
#pragma unroll
                    for (int e = 0; e < 4; ++e) { const float a = fmaxf(v0[e], 0.f), b = fmaxf(v1[e], 0.f); v0[e] = a * a; v1[e] = b * b; }
                    u32x4 w; w.x = pk_bf16(v0[0], v0[1]); w.y = pk_bf16(v0[2], v0[3]); w.z = pk_bf16(v1[0], v1[1]); w.w = pk_bf16(v1[2], v1[3]); *(u32x4*)(rowp + bj * HALF) = w; } }
    }
};

template <class Epi, class Sched, bool ALIGN_EPI = false, bool SP2 = false>
__device__ __forceinline__ void gemm_phase(PG8_LAS unsigned char* lds, const Gemm g, const Sched& S, const Epi& E) {
    const int tid = tid_fresh(), wid = __builtin_amdgcn_readfirstlane(tid >> 6), lane = tid & 63, wr = wid >> 2, wc = wid & 3, fr = lane & 15, fq = lane >> 4;
    const int K = g.K, nt = K / BK;
    unsigned voffA[2], voffB[2];
#pragma unroll
    for (int i = 0; i < 2; ++i) { int R, C; stage_rc(tid * 16 + i * 8192, R, C); const int Rb = Epi::PERM ? ((R & ~31) + perm32(R & 31)) : R;
        voffA[i] = (unsigned)(R * K + C) * 2u; voffB[i] = (unsigned)(Rb * K + C) * 2u; }
    const size_t kstep = (size_t)(BK * 2);
    const size_t hstep = (size_t)HALF * K * 2;
    const size_t tstep = 2 * hstep;
    const unsigned ldsw = (unsigned)wid * 1024u;
    const int aoff = lds_byte(wr * 64 + fr, fq * 8), boff = lds_byte(wc * 32 + fr, fq * 8);
#define PG8_SA(b, h) (((b) * 2 + (h)) * HTB)
#define PG8_SB(b, h) ((4 + (b) * 2 + (h)) * HTB)
#define PG8_STAGE(bufoff, gbase, voff) do { _Pragma("unroll") for (int _i = 0; _i < 2; ++_i) \
        __builtin_amdgcn_global_load_lds((const unsigned*)((const char*)(gbase) + (voff)[_i]), (PG8_LAS unsigned*)(lds + (bufoff) + ldsw + _i * 8192), 16, 0, 0); } while (0)
#define PG8_LDA(dst, b, h) do { _Pragma("unroll") for (int m = 0; m < 4; ++m) _Pragma("unroll") for (int k = 0; k < 2; ++k) dst[m][k] = *(const PG8_LAS bf16x8*)(lds + PG8_SA(b, h) + aoff + m * 2048 + k * 1024); } while (0)
#define PG8_LDB(dst, b, h) do { _Pragma("unroll") for (int n = 0; n < 2; ++n) _Pragma("unroll") for (int k = 0; k < 2; ++k) dst[n][k] = *(const PG8_LAS bf16x8*)(lds + PG8_SB(b, h) + boff + n * 2048 + k * 1024); } while (0)
#define PG8_MMA(ai, bj, At, Bt) do { __builtin_amdgcn_s_setprio(1); _Pragma("unroll") for (int m = 0; m < 4; ++m) _Pragma("unroll") for (int n = 0; n < 2; ++n) _Pragma("unroll") for (int k = 0; k < 2; ++k) \
        acc[ai][bj][m][n] = __builtin_amdgcn_mfma_f32_16x16x32_bf16(Bt[n][k], At[m][k], acc[ai][bj][m][n], 0, 0, 0); __builtin_amdgcn_s_setprio(0); } while (0)
#define PG8_WAIT_V(n) asm volatile("s_waitcnt vmcnt(" #n ")" ::: "memory")
#define PG8_WAIT_L(n) asm volatile("s_waitcnt lgkmcnt(" #n ")" ::: "memory")
#define PG8_BAR __builtin_amdgcn_s_barrier()
#define PG8_SCHED __builtin_amdgcn_sched_barrier(0)
    Unit cur, nxt; int ui = 0;
    if (!S.next(0, cur)) return;
    f32x4 acc[2][2][4][2];
#pragma unroll
    for (int a = 0; a < 2; ++a)
#pragma unroll
        for (int b = 0; b < 2; ++b)
#pragma unroll
            for (int m = 0; m < 4; ++m)
#pragma unroll
                for (int n = 0; n < 2; ++n) acc[a][b][m][n] = (f32x4){0.f, 0.f, 0.f, 0.f};
    bf16x8 At[4][2], B0[2][2], B1[2][2];
    const char* cA = (const char*)g.A + (size_t)cur.pm * tstep; const char* cB = (const char*)g.Bt + (size_t)cur.pn * tstep;
    S.a_ready(cur);
    if constexpr (SP2) {
        PG8_STAGE(PG8_SB(0, 0), cB, voffB); PG8_STAGE(PG8_SB(0, 1), cB + hstep, voffB); PG8_STAGE(PG8_SA(0, 0), cA, voffA); PG8_STAGE(PG8_SA(0, 1), cA + hstep, voffA);
        if (wr == 1) PG8_BAR;
        PG8_WAIT_V(2); PG8_BAR;
        PG8_STAGE(PG8_SB(1, 0), cB + kstep, voffB); PG8_STAGE(PG8_SA(1, 0), cA + kstep, voffA); PG8_STAGE(PG8_SB(1, 1), cB + hstep + kstep, voffB);
        PG8_WAIT_V(6); PG8_BAR;
    } else {
        PG8_STAGE(PG8_SB(0, 0), cB, voffB); PG8_STAGE(PG8_SA(0, 0), cA, voffA); PG8_STAGE(PG8_SB(0, 1), cB + hstep, voffB); PG8_STAGE(PG8_SA(0, 1), cA + hstep, voffA);
        if (wr == 1) PG8_BAR;
        PG8_WAIT_V(4); PG8_BAR;
        PG8_STAGE(PG8_SB(1, 0), cB + kstep, voffB); PG8_STAGE(PG8_SA(1, 0), cA + kstep, voffA); PG8_STAGE(PG8_SB(1, 1), cB + hstep + kstep, voffB);
        PG8_WAIT_V(6); PG8_BAR;
    }
    for (;;) {
        const bool has_next = S.next(ui + 1, nxt);
        const char* nA = has_next ? (const char*)g.A + (size_t)nxt.pm * tstep : cA; const char* nB = has_next ? (const char*)g.Bt + (size_t)nxt.pn * tstep : cB;
        for (int t = 0; t < nt; t += 2) {
            const bool last = (t == nt - 2);
            const char* a1 = cA + (size_t)(t + 1) * kstep;
            const char* a2 = last ? nA : cA + (size_t)(t + 2) * kstep; const char* b2 = last ? nB : cB + (size_t)(t + 2) * kstep;
            const char* a3 = a2 + kstep; const char* b3 = b2 + kstep;
            if (last && has_next) S.a_ready(nxt);
            if constexpr (SP2) {
            PG8_LDB(B0, 0, 0); PG8_LDB(B1, 0, 1); PG8_SCHED; PG8_LDA(At, 0, 0); PG8_STAGE(PG8_SA(1, 1), a1 + hstep, voffA);
            PG8_WAIT_V(8); PG8_WAIT_L(0); PG8_BAR; PG8_MMA(0, 0, At, B0); PG8_MMA(0, 1, At, B1); PG8_BAR; PG8_SCHED;
            PG8_LDA(At, 0, 1); PG8_STAGE(PG8_SB(0, 0), b2, voffB); PG8_STAGE(PG8_SB(0, 1), b2 + hstep, voffB); PG8_STAGE(PG8_SA(0, 0), a2, voffA);
            PG8_WAIT_V(8); PG8_WAIT_L(0); PG8_BAR; PG8_MMA(1, 0, At, B0); PG8_MMA(1, 1, At, B1); PG8_BAR; PG8_SCHED;
            PG8_LDB(B0, 1, 0); PG8_LDB(B1, 1, 1); PG8_SCHED; PG8_LDA(At, 1, 0); PG8_STAGE(PG8_SA(0, 1), a2 + hstep, voffA);
            PG8_WAIT_V(8); PG8_WAIT_L(0); PG8_BAR; PG8_MMA(0, 0, At, B0); PG8_MMA(0, 1, At, B1); PG8_BAR; PG8_SCHED;
            PG8_LDA(At, 1, 1); PG8_STAGE(PG8_SB(1, 0), b3, voffB); PG8_STAGE(PG8_SB(1, 1), b3 + hstep, voffB); PG8_STAGE(PG8_SA(1, 0), a3, voffA);
            PG8_WAIT_V(8); PG8_WAIT_L(0); PG8_BAR; PG8_MMA(1, 0, At, B0); PG8_MMA(1, 1, At, B1); PG8_BAR; PG8_SCHED;
            } else {
            PG8_LDB(B0, 0, 0); PG8_SCHED; PG8_LDA(At, 0, 0); PG8_STAGE(PG8_SA(1, 1), a1 + hstep, voffA);
            PG8_WAIT_L(8); PG8_BAR; PG8_WAIT_L(0); PG8_MMA(0, 0, At, B0); PG8_BAR; PG8_SCHED;
            PG8_LDB(B1, 0, 1); PG8_STAGE(PG8_SB(0, 0), b2, voffB);
            PG8_BAR; PG8_WAIT_L(0); PG8_MMA(0, 1, At, B1); PG8_BAR;
            PG8_LDA(At, 0, 1); PG8_STAGE(PG8_SA(0, 0), a2, voffA);
            PG8_BAR; PG8_WAIT_L(0); PG8_MMA(1, 0, At, B0); PG8_BAR; PG8_SCHED;
            PG8_STAGE(PG8_SB(0, 1), b2 + hstep, voffB);
            PG8_WAIT_V(6); PG8_BAR; PG8_MMA(1, 1, At, B1); PG8_BAR;
            PG8_LDB(B0, 1, 0); PG8_SCHED; PG8_LDA(At, 1, 0); PG8_STAGE(PG8_SA(0, 1), a2 + hstep, voffA);
            PG8_WAIT_L(8); PG8_BAR; PG8_WAIT_L(0); PG8_MMA(0, 0, At, B0); PG8_BAR; PG8_SCHED;
            PG8_LDB(B1, 1, 1); PG8_STAGE(PG8_SB(1, 0), b3, voffB);
            PG8_BAR; PG8_WAIT_L(0); PG8_MMA(0, 1, At, B1); PG8_BAR;
            PG8_LDA(At, 1, 1); PG8_STAGE(PG8_SA(1, 0), a3, voffA);
            PG8_BAR; PG8_WAIT_L(0); PG8_MMA(1, 0, At, B0); PG8_BAR; PG8_SCHED;
            PG8_STAGE(PG8_SB(1, 1), b3 + hstep, voffB);
            PG8_WAIT_V(6); PG8_BAR; PG8_MMA(1, 1, At, B1); PG8_BAR;
            }
        }
        if constexpr (ALIGN_EPI) { if (wr == 0) PG8_BAR; }
        if constexpr (!Epi::AFTER_DRAIN) { E(acc, cur, wr, wc, fr, fq); S.done(cur); }
        if (!has_next) break;
#pragma unroll
        for (int a = 0; a < 2; ++a)
#pragma unroll
            for (int b = 0; b < 2; ++b)
#pragma unroll
                for (int m = 0; m < 4; ++m)
#pragma unroll
                    for (int n = 0; n < 2; ++n) acc[a][b][m][n] = (f32x4){0.f, 0.f, 0.f, 0.f};
        cur = nxt; cA = nA; cB = nB; ++ui;
        if constexpr (ALIGN_EPI) { if (wr == 1) PG8_BAR; }
    }
    PG8_WAIT_V(0);
    if constexpr (!ALIGN_EPI) { if (wr == 0) PG8_BAR; }
    PG8_BAR;
    if constexpr (Epi::AFTER_DRAIN) { E.fused(acc, cur, wr, wc, fr, fq, lds, wid, lane); S.done(cur); }
#undef PG8_SA
#undef PG8_SB
#undef PG8_STAGE
#undef PG8_LDA
#undef PG8_LDB
#undef PG8_MMA
#undef PG8_WAIT_V
#undef PG8_WAIT_L
#undef PG8_BAR
#undef PG8_SCHED
}
}
namespace mk {
using pg8::bf16_t; using pg8::bf16x8; using pg8::f32x4; using pg8::u32x4;
#define LAS __attribute__((address_space(3)))
typedef float f32x16 __attribute__((ext_vector_type(16)));
typedef short s16x4 __attribute__((ext_vector_type(4)));
typedef unsigned u32x2 __attribute__((ext_vector_type(2)));
constexpr int SEQ = 8192, DM = 2048, DIN = 5636, LDU = 5632, NBIG = 13824, DFF = 8192, WBR = 512, NH = 4, HD = 128;
constexpr float LOG2E = 1.4426950408889634f;
constexpr float C2 = 0.08838834764831845f * LOG2E;
constexpr float ALPHA = 1.4142135623730951f;
constexpr float LN_EPS = 1e-5f;
constexpr size_t MiB = 1u << 20;
constexpr size_t WS_CTL = 0, WS_WIN = 1 * MiB, WS_WB = 55 * MiB, WS_WO = 63 * MiB, WS_W1 = 71 * MiB, WS_W2 = 103 * MiB, WS_U = 135 * MiB, WS_GH = 223 * MiB,
                 WS_OALL = 351 * MiB, WS_MFY = 383 * MiB, WS_MB = 447 * MiB, WS_XN = 479 * MiB, WS_LF = 511 * MiB, WS_F2 = 511 * MiB + 256 * 1024, WS_END = 512 * MiB;
constexpr int LDS_BYTES = 147456;
constexpr int NUNITS_MIX = 16 + 3 * 128;

__device__ __forceinline__ unsigned f2bf(float f) { unsigned u = __builtin_bit_cast(unsigned, f); return (u + 0x7fffu + ((u >> 16) & 1u)) >> 16; }
__device__ __forceinline__ unsigned pk2(float lo, float hi) { return f2bf(lo) | (f2bf(hi) << 16); }
__device__ __forceinline__ float bf2f(unsigned short h) { return __uint_as_float((unsigned)h << 16); }
__device__ __forceinline__ float wave_sum(float v) {
#pragma unroll
    for (int o = 1; o < 64; o <<= 1) v += __shfl_xor(v, o);
    return v;
}
#define XB_TMO      128
#define XB_XCNT(j)  (256  + 64 * (j))
#define XB_XSUB(j)  (1280 + 64 * (j))
#define XB_XGEN(j)  (2304 + 64 * (j))
#define XB_TOP      3328
#define XB_TOPGEN   3392
#define XCD_BAR_WORDS 3456
#define XB_SPIN_CAP (1u << 18)

__device__ __forceinline__ unsigned xb_ld(unsigned* p)              { return __hip_atomic_load(p, __ATOMIC_RELAXED, __HIP_MEMORY_SCOPE_AGENT); }
__device__ __forceinline__ unsigned xb_add(unsigned* p, unsigned v) { return __hip_atomic_fetch_add(p, v, __ATOMIC_RELAXED, __HIP_MEMORY_SCOPE_AGENT); }
__device__ __forceinline__ unsigned xb_xcc_id() { return (unsigned)__builtin_amdgcn_s_getreg((3 << 11) | 20) & 0xFu; }
#define XB_SPIN(cond, bar) do { unsigned _sp = 0; while (cond) { __builtin_amdgcn_s_sleep(1); \
    if ((++_sp & 255u) == 0u) { if (xb_ld(&(bar)[XB_TMO])) break; if (_sp > XB_SPIN_CAP) { atomicAdd(&(bar)[XB_TMO], 1u); break; } } } } while (0)

struct XcdBarrier {
    unsigned* bar; unsigned x;
    volatile LAS unsigned* st;
};

__device__ __forceinline__ XcdBarrier xcd_barrier_post(unsigned* bar, volatile LAS unsigned* st) {
    XcdBarrier b; b.bar = bar; b.x = xb_xcc_id(); b.st = st;
    if (threadIdx.x == 0) (void)xb_add(&bar[XB_XCNT(b.x)], 1u);
    return b;
}
__device__ __forceinline__ void xcd_barrier_complete(unsigned* bar, unsigned x, unsigned& nloc, unsigned& nx) {
    const unsigned G = gridDim.x * gridDim.y * gridDim.z;
    unsigned sum, cnt, mine, sp = 0u;
    for (;;) {
        sum = 0u; cnt = 0u; mine = 0u;
#pragma unroll
        for (unsigned j = 0; j < 16; ++j) { const unsigned c = xb_ld(&bar[XB_XCNT(j)]); sum += c; cnt += (c > 0u) ? 1u : 0u; mine = (j == x) ? c : mine; }
        if (sum == G) break;
        __builtin_amdgcn_s_sleep(1);
        if ((++sp & 255u) == 0u) { if (xb_ld(&bar[XB_TMO])) break; if (sp > XB_SPIN_CAP) { atomicAdd(&bar[XB_TMO], 1u); break; } }
    }
    nloc = mine > 0u ? mine : 1u; nx = cnt > 0u ? cnt : 1u;
}

__device__ __forceinline__ void xcd_barrier(const XcdBarrier& b) {
    asm volatile("s_waitcnt vmcnt(0)" ::: "memory");
    __syncthreads();
    if (threadIdx.x == 0) {
        unsigned* bar = b.bar;
        __builtin_amdgcn_s_waitcnt(0);
        unsigned nloc = b.st[0], nx = b.st[1];
        if (nloc == 0u) { xcd_barrier_complete(bar, b.x, nloc, nx); b.st[0] = nloc; b.st[1] = nx; }
        const unsigned old = xb_add(&bar[XB_XSUB(b.x)], 1u);
        const unsigned gen = old / nloc;
        if (old + 1u == (gen + 1u) * nloc) {
            __builtin_amdgcn_fence(__ATOMIC_RELEASE, "agent");
            asm volatile("s_waitcnt vmcnt(0)" ::: "memory");
            const unsigned og = xb_add(&bar[XB_TOP], 1u);
            const unsigned tg = og / nx;
            if (og + 1u == (tg + 1u) * nx) xb_add(&bar[XB_TOPGEN], 1u);
            else XB_SPIN(xb_ld(&bar[XB_TOPGEN]) == tg, bar);
            __builtin_amdgcn_fence(__ATOMIC_ACQUIRE, "agent");
            xb_add(&bar[XB_XGEN(b.x)], 1u);
            asm volatile("s_waitcnt vmcnt(0)" ::: "memory");
        } else {
            XB_SPIN(xb_ld(&bar[XB_XGEN(b.x)]) == gen, bar);
            __builtin_amdgcn_fence(__ATOMIC_ACQUIRE, "agent");
            asm volatile("s_waitcnt vmcnt(0)" ::: "memory");
        }
    }
    __syncthreads();
}


__device__ __forceinline__ float log_sigmoid(float x) { return fminf(x, 0.f) - log1pf(expf(-fabsf(x))); }

__device__ __forceinline__ void transpose_item(const float* __restrict__ W, int ldw, int col0, int k0, bf16_t* __restrict__ WT, int K, int row0, LAS float* scr, int lane) {
#pragma unroll 8
    for (int i = 0; i < 32; ++i) { const int kk = 2 * i + (lane >> 5); scr[kk * 33 + (lane & 31)] = W[(size_t)(k0 + kk) * ldw + col0 + (lane & 31)]; }
    asm volatile("s_waitcnt lgkmcnt(0)" ::: "memory");
    const int c = lane & 7;
#pragma unroll
    for (int j = 0; j < 4; ++j) { const int n = (lane >> 3) + 8 * j; const LAS float* s = scr + (8 * c) * 33 + n;
        u32x4 o; o.x = pk2(s[0 * 33], s[1 * 33]); o.y = pk2(s[2 * 33], s[3 * 33]); o.z = pk2(s[4 * 33], s[5 * 33]); o.w = pk2(s[6 * 33], s[7 * 33]);
        *(u32x4*)(WT + (size_t)(row0 + n) * K + k0 + 8 * c) = o; }
    asm volatile("s_waitcnt lgkmcnt(0)" ::: "memory");
}
struct Ptrs {
    const float *x, *ln_in_g, *ln_in_b, *w_in, *b_forget, *conv_w, *conv_b, *w_r, *b_r, *w_i, *b_i, *lam, *rel_bias, *w_branch, *w_gate, *b_gate, *w_out, *ln1_g, *ln1_b, *w_ff1, *w_ff2, *ln2_g, *ln2_b;
    float* out; unsigned char* ws;
};
struct Args { const float* in[23]; float* out; unsigned char* ws; };
typedef const Args __attribute__((address_space(4))) * KArgP;
__device__ __forceinline__ KArgP kargs() { KArgP p = (KArgP)__builtin_amdgcn_kernarg_segment_ptr(); asm volatile("" : "+s"(p)); return p; }
__device__ __forceinline__ void convert_weights(const Ptrs& P, int l, LAS unsigned char* lds, int gw, int ngw, int wave, int lane) {
    LAS float* scr = (LAS float*)(lds + wave * 16384);
    bf16_t* WIN = (bf16_t*)(P.ws + WS_WIN); bf16_t* WB = (bf16_t*)(P.ws + WS_WB); bf16_t* WO = (bf16_t*)(P.ws + WS_WO); bf16_t* W1 = (bf16_t*)(P.ws + WS_W1); bf16_t* W2 = (bf16_t*)(P.ws + WS_W2);
    constexpr int I_IN = 32 * 176, I_G = 4 * 32 * 64, I_B = 4 * 8 * 64, I_O = 32 * 64, I_1 = 32 * 256, I_2 = 128 * 64, NIT = I_IN + I_G + I_B + I_O + I_1 + I_2;
    for (int it = gw; it < NIT; it += ngw) {
        int r = it;
        if (r < I_IN) { const int kb = r / 176, nb = r % 176, d = 32 * nb; transpose_item(P.w_in + (size_t)l * DM * DIN, DIN, d < 1536 ? d : d + 4, 64 * kb, WIN, DM, d, scr, lane); continue; } r -= I_IN;
        if (r < I_G) { const int g = r / 2048, q = r % 2048, kb = q / 64, nb = q % 64; transpose_item(P.w_gate + (size_t)(l * 4 + g) * DM * DM, DM, 32 * nb, 64 * kb, WIN, DM, LDU + g * 2048 + 32 * nb, scr, lane); continue; } r -= I_G;
        if (r < I_B) { const int g = r / 512, q = r % 512, kb = q / 64, nb = q % 64; transpose_item(P.w_branch + (size_t)(l * 4 + g) * WBR * DM, DM, 32 * nb, 64 * kb, WB + (size_t)g * DM * WBR, WBR, 32 * nb, scr, lane); continue; } r -= I_B;
        if (r < I_O) { const int kb = r / 64, nb = r % 64; transpose_item(P.w_out + (size_t)l * DM * DM, DM, 32 * nb, 64 * kb, WO, DM, 32 * nb, scr, lane); continue; } r -= I_O;
        if (r < I_1) { const int kb = r / 256, nb = r % 256; transpose_item(P.w_ff1 + (size_t)l * DM * DFF, DFF, 32 * nb, 64 * kb, W1, DM, 32 * nb, scr, lane); continue; } r -= I_1;
        { const int kb = r / 64, nb = r % 64; transpose_item(P.w_ff2 + (size_t)l * DFF * DM, DM, 32 * nb, 64 * kb, W2, DFF, 32 * nb, scr, lane); }
    }
}
__device__ __forceinline__ void ln_rows(const float* __restrict__ src, const float* __restrict__ g, const float* __restrict__ b, float* __restrict__ dx, bf16_t* __restrict__ dxn,
                                        const float* __restrict__ wf, const float* __restrict__ bfg, float* __restrict__ lf, int gw, int ngw, int lane) {
    for (int row = gw; row < SEQ; row += ngw) {
        const float* sr = src + (size_t)row * DM + 4 * lane;
        f32x4 v[8]; float s = 0.f;
#pragma unroll
        for (int j = 0; j < 8; ++j) { v[j] = *(const f32x4*)(sr + 256 * j); s += (v[j][0] + v[j][1]) + (v[j][2] + v[j][3]); }
        const float mean = wave_sum(s) * (1.f / DM); float s2 = 0.f;
#pragma unroll
        for (int j = 0; j < 8; ++j) { v[j] = v[j] - mean; s2 += (v[j][0] * v[j][0] + v[j][1] * v[j][1]) + (v[j][2] * v[j][2] + v[j][3] * v[j][3]); }
        const float rstd = 1.0f / sqrtf(wave_sum(s2) * (1.f / DM) + LN_EPS);
        f32x4 dacc = {0.f, 0.f, 0.f, 0.f};
#pragma unroll
        for (int j = 0; j < 8; ++j) { const int c = 4 * lane + 256 * j; const f32x4 gg = *(const f32x4*)(g + c), bb = *(const f32x4*)(b + c);
            const f32x4 y = v[j] * rstd * gg + bb; v[j] = y;
            *(f32x4*)(dx + (size_t)row * DM + c) = y;
            u32x2 o; o.x = pk2(y[0], y[1]); o.y = pk2(y[2], y[3]); *(u32x2*)(dxn + (size_t)row * DM + c) = o; }
        if (wf) {
#pragma unroll
            for (int j = 0; j < 8; ++j) { const float* wp = wf + (size_t)(4 * lane + 256 * j) * DIN;
                const f32x4 w0 = *(const f32x4*)(wp), w1 = *(const f32x4*)(wp + DIN), w2 = *(const f32x4*)(wp + 2 * DIN), w3 = *(const f32x4*)(wp + 3 * DIN);
                dacc += w0 * v[j][0]; dacc += w1 * v[j][1]; dacc += w2 * v[j][2]; dacc += w3 * v[j][3];
                asm volatile("" ::: "memory"); } }
        if (wf) { float d0 = wave_sum(dacc[0]), d1 = wave_sum(dacc[1]), d2 = wave_sum(dacc[2]), d3 = wave_sum(dacc[3]);
            if (lane == 0) { f32x4 o; o[0] = log_sigmoid(d0 + bfg[0]); o[1] = log_sigmoid(d1 + bfg[1]); o[2] = log_sigmoid(d2 + bfg[2]); o[3] = log_sigmoid(d3 + bfg[3]); *(f32x4*)(lf + (size_t)row * 4) = o; } }
    }
}
__device__ __forceinline__ void cumsum_f(const float* lf, float* F2, LAS unsigned char* lds, int tid) {
    LAS f32x4* part = (LAS f32x4*)lds;
    const int lane = tid & 63, wv = tid >> 6;
    f32x4 v[16]; f32x4 s = {0.f, 0.f, 0.f, 0.f};
#pragma unroll
    for (int i = 0; i < 16; ++i) { v[i] = *(const f32x4*)(lf + (size_t)(16 * tid + i) * 4); s += v[i]; }
    f32x4 inc = s;
#pragma unroll
    for (int o = 1; o < 64; o <<= 1) { f32x4 n; n[0] = __shfl_up(inc[0], o); n[1] = __shfl_up(inc[1], o); n[2] = __shfl_up(inc[2], o); n[3] = __shfl_up(inc[3], o); if (lane >= o) inc += n; }
    if (lane == 63) part[wv] = inc;
    __syncthreads();
    f32x4 run = inc - s;
    for (int j = 0; j < wv; ++j) run += part[j];
    f32x4 o0[4], o1[4], o2[4], o3[4];
#pragma unroll
    for (int i = 0; i < 16; ++i) { run += v[i]; o0[i >> 2][i & 3] = run[0] * LOG2E; o1[i >> 2][i & 3] = run[1] * LOG2E; o2[i >> 2][i & 3] = run[2] * LOG2E; o3[i >> 2][i & 3] = run[3] * LOG2E; }
#pragma unroll
    for (int q = 0; q < 4; ++q) { *(f32x4*)(F2 + 0 * SEQ + 16 * tid + 4 * q) = o0[q]; *(f32x4*)(F2 + 1 * SEQ + 16 * tid + 4 * q) = o1[q]; *(f32x4*)(F2 + 2 * SEQ + 16 * tid + 4 * q) = o2[q]; *(f32x4*)(F2 + 3 * SEQ + 16 * tid + 4 * q) = o3[q]; }
    __syncthreads();
}
constexpr int A_K = 0, A_V = 32768, A_F2K = 65536, A_BIAS = 66048, A_FLAGS = 67328, A_UNIT = 67456;
__device__ __forceinline__ int offb(int row, int ch) { return 256 * row + 16 * (ch ^ (((row & 3) << 2) | ((row >> 2) & 3))); }
__device__ __forceinline__ s16x4 vtr(LAS const unsigned char* p) { return __builtin_bit_cast(s16x4, __builtin_amdgcn_ds_read_tr16_b64_v4i16((LAS s16x4*)p)); }
#define MFMA32(a, b, c) __builtin_amdgcn_mfma_f32_32x32x16_bf16((a), (b), (c), 0, 0, 0)
template <int S> __device__ __forceinline__ bf16x8 pack8(const f32x16& x) {
    u32x4 p; p.x = pg8::pk_bf16(x[8 * S], x[8 * S + 1]); p.y = pg8::pk_bf16(x[8 * S + 2], x[8 * S + 3]); p.z = pg8::pk_bf16(x[8 * S + 4], x[8 * S + 5]); p.w = pg8::pk_bf16(x[8 * S + 6], x[8 * S + 7]);
    return __builtin_bit_cast(bf16x8, p);
}
constexpr float FOX_TH2 = 60.0f;
constexpr float SB_RMIN = 1e-20f;

template <int MODE  >
__device__ __forceinline__ void attn_unit(LAS unsigned char* lds, const bf16_t* __restrict__ Qp, const bf16_t* __restrict__ Kp, const bf16_t* __restrict__ Vp, bf16_t* __restrict__ Op,
                                          const int qb, const float* __restrict__ F2h, const float* __restrict__ relb, const float kbnd) {
    const int tid = tid_fresh(), lane = tid & 63, w = __builtin_amdgcn_readfirstlane(tid >> 6), r = lane & 31, hh = lane >> 5;
    const int twmin = qb * 256 + w * 32, twmax = twmin + 31, t = twmin + r;
    bf16x8 qf[8];
    { const bf16_t* qrow = Qp + (size_t)t * LDU + 8 * hh;
#pragma unroll
      for (int kk = 0; kk < 8; ++kk) qf[kk] = *(const bf16x8*)(qrow + 16 * kk); }
    f32x16 O[4];
#pragma unroll
    for (int d = 0; d < 4; ++d)
#pragma unroll
        for (int i = 0; i < 16; ++i) O[d][i] = 0.f;
    float m = -INFINITY, l = 0.f, R = 1.f, f2q = 0.f, qn = 0.f;
    if (MODE == 0) { f2q = F2h[t]; float s = 0.f;
#pragma unroll
        for (int kk = 0; kk < 8; ++kk)
#pragma unroll
            for (int j = 0; j < 8; ++j) { const float v = bf2f((unsigned short)qf[kk][j]); s += v * v; }
        s += __shfl_xor(s, 32); qn = sqrtf(s) * kbnd; }
    LAS float* biasL = (LAS float*)(lds + A_BIAS);
    LAS unsigned* flags = (LAS unsigned*)(lds + A_FLAGS);
    if (MODE == 2) { for (int i = tid; i < 320; i += 512) biasL[i] = relb[i] * LOG2E; }
    const int jhi = 4 * qb + 3, jlo = (MODE == 2) ? (4 * qb - 8 > 0 ? 4 * qb - 8 : 0) : 0;
    const int srow = tid >> 4, sch = tid & 15, soff0 = offb(srow, sch), soff1 = offb(srow + 32, sch);
    const bf16_t* kg = Kp + (size_t)srow * LDU + 8 * sch; const bf16_t* vg = Vp + (size_t)srow * LDU + 8 * sch;
    u32x4 kr0, kr1, vr0, vr1; float f2r = 0.f;
#define A_LOADT(jt) do { const size_t o_ = (size_t)(jt) * 64 * LDU; kr0 = *(const u32x4*)(kg + o_); kr1 = *(const u32x4*)(kg + o_ + 32 * LDU); vr0 = *(const u32x4*)(vg + o_); vr1 = *(const u32x4*)(vg + o_ + 32 * LDU); \
        if (MODE == 0 && tid < 64) f2r = F2h[(jt) * 64 + tid]; } while (0)
#define A_STORET(b) do { *(LAS u32x4*)(lds + A_K + (b) * 16384 + soff0) = kr0; *(LAS u32x4*)(lds + A_K + (b) * 16384 + soff1) = kr1; *(LAS u32x4*)(lds + A_V + (b) * 16384 + soff0) = vr0; *(LAS u32x4*)(lds + A_V + (b) * 16384 + soff1) = vr1; \
        if (MODE == 0 && tid < 64) ((LAS float*)(lds + A_F2K + (b) * 256))[tid] = f2r; } while (0)
    A_LOADT(jhi); A_STORET(0);
    __syncthreads();
    const int xk = ((r & 3) << 2) | ((r >> 2) & 3);
    const int li = lane & 15, tq = li >> 2, tp = li & 3, rh = (lane >> 4) & 1;
    int buf = 0, it = 0; bool wdone = false;
    for (int jt = jhi; jt >= jlo; --jt, ++it) {
        const bool more = jt > jlo;
        if (more) A_LOADT(jt - 1);
        const int kb = jt * 64;
        bool active;
        if (MODE == 0) active = (kb <= twmax) && !wdone;
        else if (MODE == 1) active = (kb < twmax) && !wdone;
        else { const int cw = 4 * qb + (w >> 1); active = (jt <= cw) && (jt >= cw - 8); }
        if (active) {
            LAS const unsigned char* Kb = lds + A_K + buf * 16384; LAS const unsigned char* Vb = lds + A_V + buf * 16384;
            f32x16 X[2];
#pragma unroll
            for (int i = 0; i < 16; ++i) { X[0][i] = 0.f; X[1][i] = 0.f; }
#pragma unroll
            for (int kk = 0; kk < 8; ++kk) { const int o = 256 * r + 16 * ((2 * kk + hh) ^ xk);
                const bf16x8 k0 = *(LAS const bf16x8*)(Kb + o), k1 = *(LAS const bf16x8*)(Kb + o + 8192);
                X[0] = MFMA32(k0, qf[kk], X[0]); X[1] = MFMA32(k1, qf[kk], X[1]); }
            if (MODE == 0 || MODE == 2) {
                float mx = -INFINITY;
                if (MODE == 0) { LAS const float* f2k = (LAS const float*)(lds + A_F2K + buf * 256); const bool needmask = (kb + 63 > twmin);
#pragma unroll
                    for (int b = 0; b < 2; ++b)
#pragma unroll
                        for (int g = 0; g < 4; ++g) { const f32x4 fk = *(LAS const f32x4*)(f2k + 32 * b + 8 * g + 4 * hh);
#pragma unroll
                            for (int c = 0; c < 4; ++c) { float s = X[b][4 * g + c] + (f2q - fk[c]); if (needmask && (kb + 32 * b + 8 * g + 4 * hh + c > t)) s = -INFINITY; X[b][4 * g + c] = s; mx = fmaxf(mx, s); } }
                } else {
#pragma unroll
                    for (int b = 0; b < 2; ++b)
#pragma unroll
                        for (int i = 0; i < 16; ++i) { const int key = kb + 32 * b + 8 * (i >> 2) + 4 * hh + (i & 3); int dist = t - key; dist = dist < -63 ? -63 : (dist > 256 ? 256 : dist);
                            const float s = X[b][i] + biasL[dist + 63]; X[b][i] = s; mx = fmaxf(mx, s); }
                }
                mx = fmaxf(mx, __shfl_xor(mx, 32));
                const float mnew = fmaxf(m, mx), msafe = (mnew == -INFINITY) ? 0.f : mnew;
                const float alpha = __builtin_amdgcn_exp2f(m - msafe);
                float ps = 0.f;
#pragma unroll
                for (int b = 0; b < 2; ++b)
#pragma unroll
                    for (int i = 0; i < 16; ++i) { const float p = __builtin_amdgcn_exp2f(X[b][i] - msafe); X[b][i] = p; ps += p; }
                l = l * alpha + ps; m = mnew;
                if (!__all(alpha == 1.0f)) {
#pragma unroll
                    for (int d = 0; d < 4; ++d)
#pragma unroll
                        for (int i = 0; i < 16; ++i) O[d][i] *= alpha; }
            } else {
                const bool needmask = (kb + 63 >= twmin);
                f32x16 OM[2];
#pragma unroll
                for (int b = 0; b < 2; ++b)
#pragma unroll
                    for (int i = 0; i < 16; ++i) { const float e = __builtin_amdgcn_exp2f(fminf(X[b][i], 115.0f)); float omb = __builtin_amdgcn_rcpf(1.0f + e); float beta = e * omb;
                        if (needmask && (kb + 32 * b + 8 * (i >> 2) + 4 * hh + (i & 3) >= t)) { omb = 1.0f; beta = 0.f; }
                        OM[b][i] = omb; X[b][i] = beta; }
                float Rr = R;
#pragma unroll
                for (int b = 1; b >= 0; --b)
#pragma unroll
                    for (int g = 3; g >= 0; --g) { const float G = (OM[b][4 * g] * OM[b][4 * g + 1]) * (OM[b][4 * g + 2] * OM[b][4 * g + 3]); const float Gp = __shfl_xor(G, 32);
                        const float E = hh ? Rr : Rr * Gp; Rr = Rr * (G * Gp);
                        const float w3 = E, w2 = w3 * OM[b][4 * g + 3], w1 = w2 * OM[b][4 * g + 2], w0 = w1 * OM[b][4 * g + 1];
                        X[b][4 * g + 3] *= w3; X[b][4 * g + 2] *= w2; X[b][4 * g + 1] *= w1; X[b][4 * g] *= w0; }
                R = Rr;
            }
            const bf16x8 p00 = pack8<0>(X[0]), p01 = pack8<1>(X[0]), p10 = pack8<0>(X[1]), p11 = pack8<1>(X[1]);
#pragma unroll
            for (int db = 0; db < 4; ++db) {
#pragma unroll
                for (int bs = 0; bs < 4; ++bs) {
                    s16x4 v[2];
#pragma unroll
                    for (int jj = 0; jj < 2; ++jj) { const int xr = (tq << 2) | (2 * jj + hh); const int ch = (4 * db + 2 * rh + (tp >> 1)) ^ xr;
                        v[jj] = vtr(Vb + 256 * (16 * bs + 8 * jj + 4 * hh + tq) + 16 * ch + 8 * (tp & 1)); }
                    bf16x8 vf; vf[0] = v[0][0]; vf[1] = v[0][1]; vf[2] = v[0][2]; vf[3] = v[0][3]; vf[4] = v[1][0]; vf[5] = v[1][1]; vf[6] = v[1][2]; vf[7] = v[1][3];
                    O[db] = MFMA32(vf, bs == 0 ? p00 : (bs == 1 ? p01 : (bs == 2 ? p10 : p11)), O[db]); } }
            if (MODE == 0) { const float fk0 = ((LAS const float*)(lds + A_F2K + buf * 256))[0]; wdone = __all((qn + f2q - fk0 - m) < -FOX_TH2); }
            if (MODE == 1) wdone = __all(R < SB_RMIN);
        }
        if (more) A_STORET(buf ^ 1);
        if (MODE != 2) { if (lane == 0) flags[(it & 1) * 8 + w] = wdone ? 1u : 0u; }
        __syncthreads();
        if (MODE != 2) { unsigned a = 1u;
#pragma unroll
            for (int i = 0; i < 8; ++i) a &= flags[(it & 1) * 8 + i];
            if (a) break; }
        buf ^= 1;
    }
#undef A_LOADT
#undef A_STORET
    float sc = 1.0f;
    if (MODE != 1) { const float lt = l + __shfl_xor(l, 32); sc = 1.0f / lt; }
    bf16_t* orow = Op + (size_t)t * WBR + 4 * hh;
#pragma unroll
    for (int db = 0; db < 4; ++db)
#pragma unroll
        for (int g = 0; g < 4; ++g) { u32x2 o; o.x = pg8::pk_bf16(O[db][4 * g] * sc, O[db][4 * g + 1] * sc); o.y = pg8::pk_bf16(O[db][4 * g + 2] * sc, O[db][4 * g + 3] * sc);
            *(u32x2*)(orow + 32 * db + 8 * g) = o; }
}
constexpr int L_WR = 0, L_WI = 8704, L_RAW = 17408, L_XC = 50944, L_A = 85760, L_INP = 102144, L_RY = 118528, L_AH = 126720, L_CARRY = 130816, L_PAR = 131072;
__device__ __forceinline__ float gelu_tanh(float y) { const float u = 0.7978845608028654f * (y + 0.044715f * y * y * y); const float th = 1.0f - 2.0f / (1.0f + __expf(2.0f * u)); return 0.5f * y * (1.0f + th); }
__device__ __forceinline__ void lru_unit(LAS unsigned char* lds, const int l, const int n, const int cs, const bf16_t* __restrict__ U, bf16_t* __restrict__ Oout) {
    const int tid = tid_fresh(), lane = tid & 63, w = __builtin_amdgcn_readfirstlane(tid >> 6);
    const int ch0 = n * 128, oc0 = ch0 + 32 * cs;
    LAS float* par = (LAS float*)(lds + L_PAR);
    LAS float* carry = (LAS float*)(lds + L_CARRY);
    {
        KArgP k = kargs(); Ptrs P; P.w_r = k->in[7]; P.b_r = k->in[8]; P.w_i = k->in[9]; P.b_i = k->in[10]; P.lam = k->in[11]; P.conv_w = k->in[5]; P.conv_b = k->in[6];
        const float* wr = P.w_r + (size_t)(l * 4 + n) * 128 * 128; const float* wi = P.w_i + (size_t)(l * 4 + n) * 128 * 128;
        for (int idx = tid; idx < 128 * 32; idx += 512) { const int c = idx >> 5, d = idx & 31;
            *(LAS unsigned short*)(lds + L_WR + d * 272 + 2 * c) = (unsigned short)f2bf(wr[c * 128 + 32 * cs + d]);
            *(LAS unsigned short*)(lds + L_WI + d * 272 + 2 * c) = (unsigned short)f2bf(wi[c * 128 + 32 * cs + d]); }
        if (tid < 32) { par[tid] = 8.0f * log_sigmoid(P.lam[l * 512 + oc0 + tid]); par[32 + tid] = P.b_r[l * 512 + oc0 + tid]; par[64 + tid] = P.b_i[l * 512 + oc0 + tid]; carry[tid] = 0.f; carry[32 + tid] = 0.f; }
        if (tid < 128) { par[96 + tid] = P.conv_b[l * 512 + ch0 + tid];
#pragma unroll
            for (int j = 0; j < 4; ++j) par[224 + j * 128 + tid] = P.conv_w[(size_t)(l * 4 + j) * 512 + ch0 + tid]; }
    }
    const bf16_t* rxg = U + 1536 + ch0; const bf16_t* ryg = U + 2048 + oc0;
    u32x4 raw[5], ryr;
#define L_LOADT(t0) do { _Pragma("unroll") for (int i = 0; i < 5; ++i) { const int cidx = tid + 512 * i; const int row = cidx >> 4, ch = cidx & 15; const int tt = (t0) - 3 + row; \
            raw[i] = (u32x4){0u, 0u, 0u, 0u}; if (row < 131 && tt >= 0) raw[i] = *(const u32x4*)(rxg + (size_t)tt * LDU + 8 * ch); } \
        ryr = *(const u32x4*)(ryg + (size_t)((t0) + (tid >> 2)) * LDU + 8 * (tid & 3)); } while (0)
    L_LOADT(0);
    for (int ti = 0; ti < 64; ++ti) {
        const int t0 = ti * 128;
#pragma unroll
        for (int i = 0; i < 5; ++i) { const int cidx = tid + 512 * i; if (cidx < 131 * 16) *(LAS u32x4*)(lds + L_RAW + cidx * 16) = raw[i]; }
        *(LAS u32x4*)(lds + L_RY + tid * 16) = ryr;
        __syncthreads();
        if (ti + 1 < 64) L_LOADT(t0 + 128);
        { const int tok = tid >> 2, qd = tid & 3;
#pragma unroll
          for (int v = 0; v < 4; ++v) { const int c0 = 32 * qd + 8 * v; float xc[8];
#pragma unroll
              for (int e = 0; e < 8; ++e) xc[e] = par[96 + c0 + e];
#pragma unroll
              for (int j = 0; j < 4; ++j) { const u32x4 rw = *(LAS const u32x4*)(lds + L_RAW + (tok + j) * 256 + 2 * c0);
                  const unsigned ww[4] = {rw.x, rw.y, rw.z, rw.w};
#pragma unroll
                  for (int e = 0; e < 4; ++e) { xc[2 * e] += __uint_as_float(ww[e] << 16) * par[224 + j * 128 + c0 + 2 * e]; xc[2 * e + 1] += __uint_as_float(ww[e] & 0xffff0000u) * par[224 + j * 128 + c0 + 2 * e + 1]; } }
              u32x4 o; o.x = pk2(xc[0], xc[1]); o.y = pk2(xc[2], xc[3]); o.z = pk2(xc[4], xc[5]); o.w = pk2(xc[6], xc[7]);
              *(LAS u32x4*)(lds + L_XC + tok * 272 + 2 * c0) = o; } }
        __syncthreads();
        { const int fr = lane & 15, fq = lane >> 4;
          f32x4 ar[2], ai[2];
#pragma unroll
          for (int ct = 0; ct < 2; ++ct) { ar[ct] = (f32x4){0.f, 0.f, 0.f, 0.f}; ai[ct] = (f32x4){0.f, 0.f, 0.f, 0.f}; }
#pragma unroll
          for (int kk = 0; kk < 4; ++kk) { const bf16x8 a = *(LAS const bf16x8*)(lds + L_XC + (16 * w + fr) * 272 + 2 * (32 * kk + 8 * fq));
#pragma unroll
              for (int ct = 0; ct < 2; ++ct) { const bf16x8 br_ = *(LAS const bf16x8*)(lds + L_WR + (16 * ct + fr) * 272 + 2 * (32 * kk + 8 * fq)); const bf16x8 bi_ = *(LAS const bf16x8*)(lds + L_WI + (16 * ct + fr) * 272 + 2 * (32 * kk + 8 * fq));
                  ar[ct] = __builtin_amdgcn_mfma_f32_16x16x32_bf16(a, br_, ar[ct], 0, 0, 0); ai[ct] = __builtin_amdgcn_mfma_f32_16x16x32_bf16(a, bi_, ai[ct], 0, 0, 0); } }
#pragma unroll
          for (int ct = 0; ct < 2; ++ct) { const int d = 16 * ct + fr, c = 32 * cs + d;
#pragma unroll
              for (int rg = 0; rg < 4; ++rg) { const int tt = 16 * w + 4 * fq + rg;
                  const float rgate = pg8::sigmoidf_(ar[ct][rg] + par[32 + d]), igate = pg8::sigmoidf_(ai[ct][rg] + par[64 + d]);
                  const float la = rgate * par[d]; const float a = __expf(la); const float mult = sqrtf(fmaxf(-expm1f(2.0f * la), 0.f));
                  float xcf = par[96 + c];
#pragma unroll
                  for (int j = 0; j < 4; ++j) xcf += bf2f(*(LAS const unsigned short*)(lds + L_RAW + (tt + j) * 256 + 2 * c)) * par[224 + j * 128 + c];
                  ((LAS float*)(lds + L_A))[tt * 32 + d] = a; ((LAS float*)(lds + L_INP))[tt * 32 + d] = mult * igate * xcf; } } }
        __syncthreads();
        { const int d = tid & 31, sub = tid >> 5;
          LAS const float* Aa = (LAS const float*)(lds + L_A) + (8 * sub) * 32 + d; LAS const float* Ii = (LAS const float*)(lds + L_INP) + (8 * sub) * 32 + d;
          float av[8], iv[8], A = 1.f, H = 0.f;
#pragma unroll
          for (int i = 0; i < 8; ++i) { av[i] = Aa[i * 32]; iv[i] = Ii[i * 32]; H = av[i] * H + iv[i]; A *= av[i]; }
          LAS float* AH = (LAS float*)(lds + L_AH);
          AH[(sub * 32 + d) * 2] = A; AH[(sub * 32 + d) * 2 + 1] = H;
          __syncthreads();
          float h = carry[(ti & 1) * 32 + d];
          for (int s = 0; s < sub; ++s) h = AH[(s * 32 + d) * 2] * h + AH[(s * 32 + d) * 2 + 1];
#pragma unroll
          for (int i = 0; i < 8; ++i) { h = av[i] * h + iv[i]; const int tt = 8 * sub + i;
              const float y = bf2f(*(LAS const unsigned short*)(lds + L_RY + tt * 64 + 2 * d));
              Oout[(size_t)(t0 + tt) * WBR + oc0 + d] = (unsigned short)f2bf(h * gelu_tanh(y)); }
          if (sub == 15) carry[((ti + 1) & 1) * 32 + d] = h; }
        __syncthreads();
    }
#undef L_LOADT
}
constexpr int LDS_UNIT = 147392, CW_BAR = 4096;
__device__ __forceinline__ Ptrs make_ptrs(KArgP k) {
    Ptrs P;
    P.x = k->in[0]; P.ln_in_g = k->in[1]; P.ln_in_b = k->in[2]; P.w_in = k->in[3]; P.b_forget = k->in[4]; P.conv_w = k->in[5]; P.conv_b = k->in[6]; P.w_r = k->in[7]; P.b_r = k->in[8]; P.w_i = k->in[9]; P.b_i = k->in[10];
    P.lam = k->in[11]; P.rel_bias = k->in[12]; P.w_branch = k->in[13]; P.w_gate = k->in[14]; P.b_gate = k->in[15]; P.w_out = k->in[16]; P.ln1_g = k->in[17]; P.ln1_b = k->in[18]; P.w_ff1 = k->in[19]; P.w_ff2 = k->in[20];
    P.ln2_g = k->in[21]; P.ln2_b = k->in[22]; P.out = k->out; P.ws = k->ws;
    return P;
}
__global__ void __launch_bounds__(512, 2) fwd_megakernel(Args a_unused) {
    extern __shared__ __attribute__((aligned(16))) unsigned char lds_raw[];
    LAS unsigned char* lds = (LAS unsigned char*)lds_raw;
    cg::grid_group grid = cg::this_grid();
    if (threadIdx.x < 2) ((volatile LAS unsigned*)(lds + LDS_UNIT + 16))[threadIdx.x] = 0u;
    __syncthreads();
    const XcdBarrier bar = xcd_barrier_post((unsigned*)(kargs()->ws + WS_CTL) + CW_BAR, (volatile LAS unsigned*)(lds + LDS_UNIT + 16));
#define MK_IDS() const int tid = tid_fresh(), lane = tid & 63, wave = __builtin_amdgcn_readfirstlane(tid >> 6); const int G = gridDim.x, bx = blockIdx.x; \
    const int vcu = (G % 8 == 0) ? (bx % 8) * (G / 8) + bx / 8 : bx; const int gw = vcu * 8 + wave, ngw = G * 8; (void)lane; (void)gw; (void)ngw; (void)tid;
    { MK_IDS(); KArgP k = kargs(); const Ptrs P = make_ptrs(k);
      convert_weights(P, 0, lds, gw, ngw, wave, lane);
      ln_rows(P.x, P.ln_in_g, P.ln_in_b, P.out, (bf16_t*)(P.ws + WS_XN), P.w_in + 1536, P.b_forget, (float*)(P.ws + WS_LF), gw, ngw, lane); }
    grid.sync();
#pragma unroll 1
    for (int l = 0; l < 2; ++l) {
        { MK_IDS(); KArgP k = kargs(); unsigned char* ws = k->ws;
          if (bx == G - 1) cumsum_f((const float*)(ws + WS_LF), (float*)(ws + WS_F2), lds, tid);
          pg8::Gemm g{(const bf16_t*)(ws + WS_XN), (const bf16_t*)(ws + WS_WIN), SEQ, NBIG, DM}; pg8::StaticOrder S; S.init(SEQ, NBIG, G, bx);
          pg8::EpiIn E{(bf16_t*)(ws + WS_U), (bf16_t*)(ws + WS_GH), k->in[15] + (size_t)l * 4 * DM, (unsigned*)(ws + WS_CTL) + 16 + 16 * l, C2};
          pg8::gemm_phase<pg8::EpiIn, pg8::StaticOrder, true, true>(lds, g, S, E); }
        xcd_barrier(bar);
        { MK_IDS(); KArgP k = kargs(); unsigned char* ws = k->ws; unsigned* ctl = (unsigned*)(ws + WS_CTL);
          const bf16_t* U = (const bf16_t*)(ws + WS_U); bf16_t* OALL = (bf16_t*)(ws + WS_OALL); const float* F2 = (const float*)(ws + WS_F2);
            for (;;) {
                if (tid == 0) *(LAS int*)(lds + LDS_UNIT) = (int)atomicAdd(ctl + l, 1u);
                __syncthreads();
                const int unit = __builtin_amdgcn_readfirstlane(*(LAS int*)(lds + LDS_UNIT));
                __syncthreads();
                if (unit >= NUNITS_MIX) break;
                if (unit < 16) { lru_unit(lds, l, unit >> 2, unit & 3, U, OALL + (size_t)1 * SEQ * WBR); }
                else if (unit < 144) { const int kq = unit - 16, qb = 31 - (kq >> 2), h = kq & 3;
                    float s = 0.f;
#pragma unroll
                    for (int c = 0; c < 4; ++c) s += __uint_as_float(__hip_atomic_load(ctl + 16 + 16 * l + h * 4 + c, __ATOMIC_RELAXED, __HIP_MEMORY_SCOPE_AGENT));
                    attn_unit<0>(lds, U + h * HD, U + 512 + h * HD, U + 1024 + h * HD, OALL + h * HD, qb, F2 + (size_t)h * SEQ, nullptr, sqrtf(s) * 1.02f); }
                else if (unit < 272) { const int kq = unit - 144, qb = kq >> 2, h = kq & 3;
                    attn_unit<2>(lds, U + 4096 + h * HD, U + 4608 + h * HD, U + 5120 + h * HD, OALL + (size_t)3 * SEQ * WBR + h * HD, qb, nullptr, kargs()->in[12] + (size_t)(l * 4 + h) * 320, 0.f); }
                else { const int kq = unit - 272, qb = kq >> 2, h = kq & 3;
                    attn_unit<1>(lds, U + 2560 + h * HD, U + 3072 + h * HD, U + 3584 + h * HD, OALL + (size_t)2 * SEQ * WBR + h * HD, qb, nullptr, nullptr, 0.f); }
            }
        }
        xcd_barrier(bar);
        { MK_IDS(); KArgP k = kargs(); unsigned char* ws = k->ws;
          pg8::Gemm g{(const bf16_t*)(ws + WS_OALL), (const bf16_t*)(ws + WS_WB), SEQ, DM, WBR}; pg8::BranchOrder S{G, bx};
          pg8::EpiBranch E{(const bf16_t*)(ws + WS_GH), (float*)(ws + WS_MFY), (bf16_t*)(ws + WS_MB)};
          pg8::gemm_phase<pg8::EpiBranch, pg8::BranchOrder, true, true>(lds, g, S, E); }
        xcd_barrier(bar);
        { MK_IDS(); KArgP k = kargs(); unsigned char* ws = k->ws;
          pg8::Gemm g{(const bf16_t*)(ws + WS_MB), (const bf16_t*)(ws + WS_WO), SEQ, DM, DM}; pg8::StaticOrder S; S.init(SEQ, DM, G, bx);
          pg8::EpiResid E{k->out, (float*)(ws + WS_MFY), ALPHA};
          pg8::gemm_phase<pg8::EpiResid, pg8::StaticOrder, true, true>(lds, g, S, E); }
        xcd_barrier(bar);
        { MK_IDS(); KArgP k = kargs(); unsigned char* ws = k->ws;
          ln_rows((const float*)(ws + WS_MFY), k->in[17] + (size_t)l * DM, k->in[18] + (size_t)l * DM, k->out, (bf16_t*)(ws + WS_XN), nullptr, nullptr, nullptr, gw, ngw, lane); }
        xcd_barrier(bar);
        { MK_IDS(); KArgP k = kargs(); unsigned char* ws = k->ws;
          pg8::Gemm g{(const bf16_t*)(ws + WS_XN), (const bf16_t*)(ws + WS_W1), SEQ, DFF, DM}; pg8::StaticOrder S; S.init(SEQ, DFF, G, bx);
          pg8::EpiRelu2 E{(bf16_t*)(ws + WS_GH)};
          pg8::gemm_phase<pg8::EpiRelu2, pg8::StaticOrder, true, true>(lds, g, S, E); }
        xcd_barrier(bar);
        { MK_IDS(); KArgP k = kargs(); unsigned char* ws = k->ws;
          pg8::Gemm g{(const bf16_t*)(ws + WS_GH), (const bf16_t*)(ws + WS_W2), SEQ, DM, DFF}; pg8::StaticOrder S; S.init(SEQ, DM, G, bx);
          pg8::EpiResid E{k->out, (float*)(ws + WS_MFY), ALPHA};
          pg8::gemm_phase<pg8::EpiResid, pg8::StaticOrder, true, true>(lds, g, S, E); }
        xcd_barrier(bar);
        { MK_IDS(); KArgP k = kargs(); const Ptrs P = make_ptrs(k); unsigned char* ws = P.ws;
          if (l == 0) {
            ln_rows((const float*)(ws + WS_MFY), P.ln2_g, P.ln2_b, P.out, (bf16_t*)(ws + WS_XN), P.w_in + (size_t)DM * DIN + 1536, P.b_forget + 4, (float*)(ws + WS_LF), gw, ngw, lane);
            convert_weights(P, 1, lds, gw, ngw, wave, lane);
          } else {
            ln_rows((const float*)(ws + WS_MFY), P.ln2_g + DM, P.ln2_b + DM, P.out, (bf16_t*)(ws + WS_XN), nullptr, nullptr, nullptr, gw, ngw, lane);
          } }
        if (l == 0) xcd_barrier(bar);
    }
}
}

extern "C" void kernel_launch(void* const* d_in, const int* in_sizes, int n_in, void* d_out, int out_size, void* d_ws, size_t ws_size, hipStream_t stream) {
    static int grid = 0;
    if (grid == 0) {
        if (n_in != 23 || out_size != mk::SEQ * mk::DM || ws_size < mk::WS_END) { fprintf(stderr, "kernel_launch: unexpected problem (n_in %d, out %d, ws %zu)\n", n_in, out_size, ws_size); grid = -1; return; }
        int dev = 0, cus = 0, per_cu = 0;
        hipGetDevice(&dev); hipDeviceGetAttribute(&cus, hipDeviceAttributeMultiprocessorCount, dev);
        if (hipFuncSetAttribute((const void*)mk::fwd_megakernel, hipFuncAttributeMaxDynamicSharedMemorySize, mk::LDS_BYTES) != hipSuccess) { fprintf(stderr, "kernel_launch: hipFuncSetAttribute failed\n"); grid = -1; return; }
        if (hipOccupancyMaxActiveBlocksPerMultiprocessor(&per_cu, (const void*)mk::fwd_megakernel, 512, mk::LDS_BYTES) != hipSuccess || per_cu < 1) { fprintf(stderr, "kernel_launch: occupancy query gave %d\n", per_cu); per_cu = 1; (void)hipGetLastError(); }
        grid = cus * per_cu;
    }
    if (grid < 0) return;
    (void)hipMemsetAsync((char*)d_ws + mk::WS_CTL, 0, 65536, stream);
    mk::Args a{};
    for (int i = 0; i < 23; ++i) a.in[i] = (const float*)d_in[i];
    a.out = (float*)d_out; a.ws = (unsigned char*)d_ws;
    void* args[] = {&a};
    hipError_t e = hipLaunchCooperativeKernel((const void*)mk::fwd_megakernel, dim3(grid), dim3(512), args, mk::LDS_BYTES, stream);
    if (e != hipSuccess) fprintf(stderr, "cooperative launch failed: %s (grid %d)\n", hipGetErrorString(e), grid);
}
```

```cpp
#include <hip/hip_runtime.h>
#include <hip/hip_cooperative_groups.h>
#include <cstdio>
#include <cstdint>
namespace cg = cooperative_groups;
__device__ __forceinline__ int tid_fresh() { int t = threadIdx.x; asm volatile("" : "+v"(t)); return t; }
namespace pg8 {
#define PG8_LAS __attribute__((address_space(3)))
typedef unsigned short bf16_t;
typedef short bf16x8 __attribute__((ext_vector_type(8)));
typedef float f32x4 __attribute__((ext_vector_type(4)));
typedef unsigned u32x4 __attribute__((ext_vector_type(4)));
constexpr int BM = 256, BK = 64, HALF = 128, HTB = HALF * BK * 2  , STAGE_BYTES = 8 * HTB, NXCD = 8, WGM = 8;

__host__ __device__ __forceinline__ int lds_byte(int r, int c) { const int st = (r >> 4) * 2 + (c >> 5), rr = r & 15, cc = c & 31, ob = rr * 64 + cc * 2; return st * 1024 + (ob ^ (((ob >> 9) & 1) << 5)); }
__host__ __device__ __forceinline__ void stage_rc(int b, int& R, int& C) { const int st = b / 1024, sb = b % 1024, swz = sb ^ (((sb >> 9) & 1) << 5); R = (st >> 1) * 16 + swz / 64; C = (st & 1) * 32 + (swz % 64) / 2; }
__host__ __device__ __forceinline__ int perm32(int rho) { const int n = rho >> 4, i = rho & 15; return 8 * (i >> 2) + 4 * n + (i & 3); }

struct Unit { int pm, pn; };
struct Gemm { const bf16_t* A; const bf16_t* Bt; int M, N, K; };

struct StaticOrder {
    int nM, nN, nwg, G, c;
    __host__ __device__ void init(int M, int N, int G_, int c_) { nM = M / BM; nN = N / BM; nwg = nM * nN; G = G_; c = c_; }
    __host__ __device__ bool next(int i, Unit& u) const {
        const long L = (long)i * G + c; if (L >= nwg) return false;
        int wgid = (int)L; { const int q = nwg / NXCD, r = nwg % NXCD, xcd = wgid % NXCD, off = wgid / NXCD; wgid = (xcd < r ? xcd * (q + 1) : r * (q + 1) + (xcd - r) * q) + off; }
        const int nig = WGM * nN, gid = wgid / nig, fm = gid * WGM, gsz = (nM - fm) < WGM ? (nM - fm) : WGM;
        u.pm = fm + ((wgid % nig) % gsz); u.pn = (wgid % nig) / gsz; return true;
    }
    __device__ __forceinline__ void a_ready(const Unit&) const {}
    __device__ __forceinline__ void done(const Unit&) const {}
};

__device__ __forceinline__ unsigned cvt_pk_bf16(float lo, float hi) { unsigned r; asm volatile("v_cvt_pk_bf16_f32 %0, %1, %2" : "=v"(r) : "v"(lo), "v"(hi)); return r; }
__device__ __forceinline__ unsigned pk_bf16(float lo, float hi) { typedef float f2 __attribute__((ext_vector_type(2))); typedef __bf16 b2 __attribute__((ext_vector_type(2))); f2 v = {lo, hi}; b2 b = __builtin_convertvector(v, b2); return __builtin_bit_cast(unsigned, b); }
__device__ __forceinline__ float sigmoidf_(float x) { return __builtin_amdgcn_rcpf(1.0f + __builtin_amdgcn_exp2f(-1.4426950408889634f * x)); }
constexpr int LDU_ = 5632, NG_ = 8192;
struct EpiIn {
    static constexpr bool PERM = true, AFTER_DRAIN = false;
    bf16_t* U; bf16_t* G; const float* bgate; unsigned* kc2max; float c2;
    __device__ __forceinline__ void operator()(const f32x4 (&acc)[2][2][4][2], const Unit& u, int wr, int wc, int fr, int fq) const {
        const int row0 = u.pm * BM + wr * 64 + fr;
        if (u.pn < 22) {
            const bool isq = (u.pn < 2) || (u.pn == 10) || (u.pn == 11) || (u.pn == 16) || (u.pn == 17);
            const float sc = isq ? c2 : 1.0f;
            const int col0 = u.pn * BM + wc * 32 + 8 * fq;
#pragma unroll
            for (int ai = 0; ai < 2; ++ai)
#pragma unroll
                for (int m = 0; m < 4; ++m) { bf16_t* rowp = U + (size_t)(row0 + ai * HALF + m * 16) * LDU_ + col0;
#pragma unroll
                    for (int bj = 0; bj < 2; ++bj) { const f32x4 v0 = acc[ai][bj][m][0] * sc, v1 = acc[ai][bj][m][1] * sc; u32x4 w;
                        w.x = pk_bf16(v0[0], v0[1]); w.y = pk_bf16(v0[2], v0[3]); w.z = pk_bf16(v1[0], v1[1]); w.w = pk_bf16(v1[2], v1[3]); *(u32x4*)(rowp + bj * HALF) = w; } }
            if (u.pn == 2 || u.pn == 3) {
#pragma unroll
                for (int bj = 0; bj < 2; ++bj) { float mx = 0.f;
#pragma unroll
                    for (int ai = 0; ai < 2; ++ai)
#pragma unroll
                        for (int m = 0; m < 4; ++m) { const f32x4 a = acc[ai][bj][m][0], b = acc[ai][bj][m][1];
                            float s = (a[0] * a[0] + a[1] * a[1]) + (a[2] * a[2] + a[3] * a[3]) + (b[0] * b[0] + b[1] * b[1]) + (b[2] * b[2] + b[3] * b[3]);
                            s += __shfl_xor(s, 16); s += __shfl_xor(s, 32); mx = fmaxf(mx, s); }
                    mx = fmaxf(mx, __shfl_xor(mx, 1)); mx = fmaxf(mx, __shfl_xor(mx, 2)); mx = fmaxf(mx, __shfl_xor(mx, 4)); mx = fmaxf(mx, __shfl_xor(mx, 8));
                    if (fr == 0 && fq == 0) atomicMax(kc2max + ((u.pn - 2) * 2 + bj) * 4 + wc, __float_as_uint(mx)); }
            }
        } else {
            const int gcol0 = (u.pn - 22) * BM + wc * 32 + 8 * fq;
#pragma unroll
            for (int bj = 0; bj < 2; ++bj) { const f32x4 b0 = *(const f32x4*)(bgate + gcol0 + bj * HALF), b1 = *(const f32x4*)(bgate + gcol0 + bj * HALF + 4);
#pragma unroll
                for (int ai = 0; ai < 2; ++ai)
#pragma unroll
                    for (int m = 0; m < 4; ++m) { const f32x4 v0 = acc[ai][bj][m][0] + b0, v1 = acc[ai][bj][m][1] + b1; u32x4 w;
                        w.x = pk_bf16(sigmoidf_(v0[0]), sigmoidf_(v0[1])); w.y = pk_bf16(sigmoidf_(v0[2]), sigmoidf_(v0[3]));
                        w.z = pk_bf16(sigmoidf_(v1[0]), sigmoidf_(v1[1])); w.w = pk_bf16(sigmoidf_(v1[2]), sigmoidf_(v1[3]));
                        *(u32x4*)(G + (size_t)(row0 + ai * HALF + m * 16) * NG_ + gcol0 + bj * HALF) = w; } }
        }
    }
};
struct EpiBranch {
    static constexpr bool PERM = true, AFTER_DRAIN = false;
    const bf16_t* G; float* MF; bf16_t* MB;
    __device__ __forceinline__ void operator()(const f32x4 (&acc)[2][2][4][2], const Unit& u, int wr, int wc, int fr, int fq) const {
        const int g = u.pm >> 5, pmr = u.pm & 31, pnr = u.pn & 7;
        const int row0 = pmr * BM + wr * 64 + fr, col0 = pnr * BM + wc * 32 + 8 * fq;
#pragma unroll
        for (int ai = 0; ai < 2; ++ai)
#pragma unroll
            for (int m = 0; m < 4; ++m) { const size_t row = (size_t)(row0 + ai * HALF + m * 16);
#pragma unroll
                for (int bj = 0; bj < 2; ++bj) { const int col = col0 + bj * HALF;
                    const u32x4 gw = *(const u32x4*)(G + row * NG_ + g * 2048 + col);
                    f32x4 g0, g1; g0[0] = __uint_as_float(gw.x << 16); g0[1] = __uint_as_float(gw.x & 0xffff0000u); g0[2] = __uint_as_float(gw.y << 16); g0[3] = __uint_as_float(gw.y & 0xffff0000u);
                    g1[0] = __uint_as_float(gw.z << 16); g1[1] = __uint_as_float(gw.z & 0xffff0000u); g1[2] = __uint_as_float(gw.w << 16); g1[3] = __uint_as_float(gw.w & 0xffff0000u);
                    f32x4 v0 = acc[ai][bj][m][0] * g0, v1 = acc[ai][bj][m][1] * g1;
                    float* mf = MF + row * 2048 + col;
                    if (g > 0) { v0 += *(const f32x4*)mf; v1 += *(const f32x4*)(mf + 4); }
                    if (g < 3) { *(f32x4*)mf = v0; *(f32x4*)(mf + 4) = v1; }
                    else { u32x4 w; w.x = pk_bf16(v0[0], v0[1]); w.y = pk_bf16(v0[2], v0[3]); w.z = pk_bf16(v1[0], v1[1]); w.w = pk_bf16(v1[2], v1[3]); *(u32x4*)(MB + row * 2048 + col) = w; } } }
    }
};
struct BranchOrder {
    int G, c;
    __device__ bool next(int i, Unit& u) const { const int tile = (i >> 2) * G + c; if (tile >= 256) return false; const int g = i & 3; u.pm = g * 32 + (tile >> 3); u.pn = g * 8 + (tile & 7); return true; }
    __device__ __forceinline__ void a_ready(const Unit&) const {}
    __device__ __forceinline__ void done(const Unit&) const {}
};
struct EpiResid {
    static constexpr bool PERM = false, AFTER_DRAIN = false;
    const float* X; float* Y; float alpha;
    __device__ __forceinline__ void operator()(const f32x4 (&acc)[2][2][4][2], const Unit& u, int wr, int wc, int fr, int fq) const {
        const int row0 = u.pm * BM + wr * 64 + fr, col0 = u.pn * BM + wc * 32 + 4 * fq;
#pragma unroll
        for (int ai = 0; ai < 2; ++ai)
#pragma unroll
            for (int m = 0; m < 4; ++m) { const size_t off = (size_t)(row0 + ai * HALF + m * 16) * 2048 + col0;
#pragma unroll
                for (int bj = 0; bj < 2; ++bj)
#pragma unroll
                    for (int n = 0; n < 2; ++n) { const f32x4 x = *(const f32x4*)(X + off + bj * HALF + n * 16); *(f32x4*)(Y + off + bj * HALF + n * 16) = x * alpha + acc[ai][bj][m][n]; } }
    }
};
struct EpiRelu2 {
    static constexpr bool PERM = true, AFTER_DRAIN = false;
    bf16_t* H;
    __device__ __forceinline__ void operator()(const f32x4 (&acc)[2][2][4][2], const Unit& u, int wr, int wc, int fr, int fq) const {
        const int row0 = u.pm * BM + wr * 64 + fr, col0 = u.pn * BM + wc * 32 + 8 * fq;
#pragma unroll
        for (int ai = 0; ai < 2; ++ai)
#pragma unroll
            for (int m = 0; m < 4; ++m) { bf16_t* rowp = H + (size_t)(row0 + ai * HALF + m * 16) * 8192 + col0;
#pragma unroll
                for (int bj = 0; bj < 2; ++bj) { f32x4 v0 = acc[ai][bj][m][0], v1 = acc[ai][bj][m][1];
#pragma unroll
                    for (int e = 0; e < 4; ++e) { const float a = fmaxf(v0[e], 0.f), b = fmaxf(v1[e], 0.f); v0[e] = a * a; v1[e] = b * b; }
                    u32x4 w; w.x = pk_bf16(v0[0], v0[1]); w.y = pk_bf16(v0[2], v0[3]); w.z = pk_bf16(v1[0], v1[1]); w.w = pk_bf16(v1[2], v1[3]); *(u32x4*)(rowp + bj * HALF) = w; } }
    }
};

template <class Epi, class Sched, bool ALIGN_EPI = false, bool SP2 = false>
__device__ __forceinline__ void gemm_phase(PG8_LAS unsigned char* lds, const Gemm g, const Sched& S, const Epi& E) {
    const int tid = tid_fresh(), wid = __builtin_amdgcn_readfirstlane(tid >> 6), lane = tid & 63, wr = wid >> 2, wc = wid & 3, fr = lane & 15, fq = lane >> 4;
    const int K = g.K, nt = K / BK;
    unsigned voffA[2], voffB[2];
#pragma unroll
    for (int i = 0; i < 2; ++i) { int R, C; stage_rc(tid * 16 + i * 8192, R, C); const int Rb = Epi::PERM ? ((R & ~31) + perm32(R & 31)) : R;
        voffA[i] = (unsigned)(R * K + C) * 2u; voffB[i] = (unsigned)(Rb * K + C) * 2u; }
    const size_t kstep = (size_t)(BK * 2);
    const size_t hstep = (size_t)HALF * K * 2;
    const size_t tstep = 2 * hstep;
    const unsigned ldsw = (unsigned)wid * 1024u;
    const int aoff = lds_byte(wr * 64 + fr, fq * 8), boff = lds_byte(wc * 32 + fr, fq * 8);
#define PG8_SA(b, h) (((b) * 2 + (h)) * HTB)
#define PG8_SB(b, h) ((4 + (b) * 2 + (h)) * HTB)
#define PG8_STAGE(bufoff, gbase, voff) do { _Pragma("unroll") for (int _i = 0; _i < 2; ++_i) \
        __builtin_amdgcn_global_load_lds((const unsigned*)((const char*)(gbase) + (voff)[_i]), (PG8_LAS unsigned*)(lds + (bufoff) + ldsw + _i * 8192), 16, 0, 0); } while (0)
#define PG8_LDA(dst, b, h) do { _Pragma("unroll") for (int m = 0; m < 4; ++m) _Pragma("unroll") for (int k = 0; k < 2; ++k) dst[m][k] = *(const PG8_LAS bf16x8*)(lds + PG8_SA(b, h) + aoff + m * 2048 + k * 1024); } while (0)
#define PG8_LDB(dst, b, h) do { _Pragma("unroll") for (int n = 0; n < 2; ++n) _Pragma("unroll") for (int k = 0; k < 2; ++k) dst[n][k] = *(const PG8_LAS bf16x8*)(lds + PG8_SB(b, h) + boff + n * 2048 + k * 1024); } while (0)
#define PG8_MMA(ai, bj, At, Bt) do { __builtin_amdgcn_s_setprio(1); _Pragma("unroll") for (int m = 0; m < 4; ++m) _Pragma("unroll") for (int n = 0; n < 2; ++n) _Pragma("unroll") for (int k = 0; k < 2; ++k) \
        acc[ai][bj][m][n] = __builtin_amdgcn_mfma_f32_16x16x32_bf16(Bt[n][k], At[m][k], acc[ai][bj][m][n], 0, 0, 0); __builtin_amdgcn_s_setprio(0); } while (0)
#define PG8_WAIT_V(n) asm volatile("s_waitcnt vmcnt(" #n ")" ::: "memory")
#define PG8_WAIT_L(n) asm volatile("s_waitcnt lgkmcnt(" #n ")" ::: "memory")
#define PG8_BAR __builtin_amdgcn_s_barrier()
#define PG8_SCHED __builtin_amdgcn_sched_barrier(0)
    Unit cur, nxt; int ui = 0;
    if (!S.next(0, cur)) return;
    f32x4 acc[2][2][4][2];
#pragma unroll
    for (int a = 0; a < 2; ++a)
#pragma unroll
        for (int b = 0; b < 2; ++b)
#pragma unroll
            for (int m = 0; m < 4; ++m)
#pragma unroll
                for (int n = 0; n < 2; ++n) acc[a][b][m][n] = (f32x4){0.f, 0.f, 0.f, 0.f};
    bf16x8 At[4][2], B0[2][2], B1[2][2];
    const char* cA = (const char*)g.A + (size_t)cur.pm * tstep; const char* cB = (const char*)g.Bt + (size_t)cur.pn * tstep;
    S.a_ready(cur);
    if constexpr (SP2) {
        PG8_STAGE(PG8_SB(0, 0), cB, voffB); PG8_STAGE(PG8_SB(0, 1), cB + hstep, voffB); PG8_STAGE(PG8_SA(0, 0), cA, voffA); PG8_STAGE(PG8_SA(0, 1), cA + hstep, voffA);
        if (wr == 1) PG8_BAR;
        PG8_WAIT_V(2); PG8_BAR;
        PG8_STAGE(PG8_SB(1, 0), cB + kstep, voffB); PG8_STAGE(PG8_SA(1, 0), cA + kstep, voffA); PG8_STAGE(PG8_SB(1, 1), cB + hstep + kstep, voffB);
        PG8_WAIT_V(6); PG8_BAR;
    } else {
        PG8_STAGE(PG8_SB(0, 0), cB, voffB); PG8_STAGE(PG8_SA(0, 0), cA, voffA); PG8_STAGE(PG8_SB(0, 1), cB + hstep, voffB); PG8_STAGE(PG8_SA(0, 1), cA + hstep, voffA);
        if (wr == 1) PG8_BAR;
        PG8_WAIT_V(4); PG8_BAR;
        PG8_STAGE(PG8_SB(1, 0), cB + kstep, voffB); PG8_STAGE(PG8_SA(1, 0), cA + kstep, voffA); PG8_STAGE(PG8_SB(1, 1), cB + hstep + kstep, voffB);
        PG8_WAIT_V(6); PG8_BAR;
    }
    for (;;) {
        const bool has_next = S.next(ui + 1, nxt);
        const char* nA = has_next ? (const char*)g.A + (size_t)nxt.pm * tstep : cA; const char* nB = has_next ? (const char*)g.Bt + (size_t)nxt.pn * tstep : cB;
        for (int t = 0; t < nt; t += 2) {
            const bool last = (t == nt - 2);
            const char* a1 = cA + (size_t)(t + 1) * kstep;
            const char* a2 = last ? nA : cA + (size_t)(t + 2) * kstep; const char* b2 = last ? nB : cB + (size_t)(t + 2) * kstep;
            const char* a3 = a2 + kstep; const char* b3 = b2 + kstep;
            if (last && has_next) S.a_ready(nxt);
            if constexpr (SP2) {
            PG8_LDB(B0, 0, 0); PG8_LDB(B1, 0, 1); PG8_SCHED; PG8_LDA(At, 0, 0); PG8_STAGE(PG8_SA(1, 1), a1 + hstep, voffA);
            PG8_WAIT_V(8); PG8_WAIT_L(0); PG8_BAR; PG8_MMA(0, 0, At, B0); PG8_MMA(0, 1, At, B1); PG8_BAR; PG8_SCHED;
            PG8_LDA(At, 0, 1); PG8_STAGE(PG8_SB(0, 0), b2, voffB); PG8_STAGE(PG8_SB(0, 1), b2 + hstep, voffB); PG8_STAGE(PG8_SA(0, 0), a2, voffA);
            PG8_WAIT_V(8); PG8_WAIT_L(0); PG8_BAR; PG8_MMA(1, 0, At, B0); PG8_MMA(1, 1, At, B1); PG8_BAR; PG8_SCHED;
            PG8_LDB(B0, 1, 0); PG8_LDB(B1, 1, 1); PG8_SCHED; PG8_LDA(At, 1, 0); PG8_STAGE(PG8_SA(0, 1), a2 + hstep, voffA);
            PG8_WAIT_V(8); PG8_WAIT_L(0); PG8_BAR; PG8_MMA(0, 0, At, B0); PG8_MMA(0, 1, At, B1); PG8_BAR; PG8_SCHED;
            PG8_LDA(At, 1, 1); PG8_STAGE(PG8_SB(1, 0), b3, voffB); PG8_STAGE(PG8_SB(1, 1), b3 + hstep, voffB); PG8_STAGE(PG8_SA(1, 0), a3, voffA);
            PG8_WAIT_V(8); PG8_WAIT_L(0); PG8_BAR; PG8_MMA(1, 0, At, B0); PG8_MMA(1, 1, At, B1); PG8_BAR; PG8_SCHED;
            } else {
            PG8_LDB(B0, 0, 0); PG8_SCHED; PG8_LDA(At, 0, 0); PG8_STAGE(PG8_SA(1, 1), a1 + hstep, voffA);
            PG8_WAIT_L(8); PG8_BAR; PG8_WAIT_L(0); PG8_MMA(0, 0, At, B0); PG8_BAR; PG8_SCHED;
            PG8_LDB(B1, 0, 1); PG8_STAGE(PG8_SB(0, 0), b2, voffB);
            PG8_BAR; PG8_WAIT_L(0); PG8_MMA(0, 1, At, B1); PG8_BAR;
            PG8_LDA(At, 0, 1); PG8_STAGE(PG8_SA(0, 0), a2, voffA);
            PG8_BAR; PG8_WAIT_L(0); PG8_MMA(1, 0, At, B0); PG8_BAR; PG8_SCHED;
            PG8_STAGE(PG8_SB(0, 1), b2 + hstep, voffB);
            PG8_WAIT_V(6); PG8_BAR; PG8_MMA(1, 1, At, B1); PG8_BAR;
            PG8_LDB(B0, 1, 0); PG8_SCHED; PG8_LDA(At, 1, 0); PG8_STAGE(PG8_SA(0, 1), a2 + hstep, voffA);
            PG8_WAIT_L(8); PG8_BAR; PG8_WAIT_L(0); PG8_MMA(0, 0, At, B0); PG8_BAR; PG8_SCHED;
            PG8_LDB(B1, 1, 1); PG8_STAGE(PG8_SB(1, 0), b3, voffB);
            PG8_BAR; PG8_WAIT_L(0); PG8_MMA(0, 1, At, B1); PG8_BAR;
            PG8_LDA(At, 1, 1); PG8_STAGE(PG8_SA(1, 0), a3, voffA);
            PG8_BAR; PG8_WAIT_L(0); PG8_MMA(1, 0, At, B0); PG8_BAR; PG8_SCHED;
            PG8_STAGE(PG8_SB(1, 1), b3 + hstep, voffB);
            PG8_WAIT_V(6); PG8_BAR; PG8_MMA(1, 1, At, B1); PG8_BAR;
            }
        }
        if constexpr (ALIGN_EPI) { if (wr == 0) PG8_BAR; }
        if constexpr (!Epi::AFTER_DRAIN) { E(acc, cur, wr, wc, fr, fq); S.done(cur); }
        if (!has_next) break;
#pragma unroll
        for (int a = 0; a < 2; ++a)
#pragma unroll
            for (int b = 0; b < 2; ++b)
#pragma unroll
                for (int m = 0; m < 4; ++m)
#pragma unroll
                    for (int n = 0; n < 2; ++n) acc[a][b][m][n] = (f32x4){0.f, 0.f, 0.f, 0.f};
        cur = nxt; cA = nA; cB = nB; ++ui;
        if constexpr (ALIGN_EPI) { if (wr == 1) PG8_BAR; }
    }
    PG8_WAIT_V(0);
    if constexpr (!ALIGN_EPI) { if (wr == 0) PG8_BAR; }
    PG8_BAR;
    if constexpr (Epi::AFTER_DRAIN) { E.fused(acc, cur, wr, wc, fr, fq, lds, wid, lane); S.done(cur); }
#undef PG8_SA
#undef PG8_SB
#undef PG8_STAGE
#undef PG8_LDA
#undef PG8_LDB
#undef PG8_MMA
#undef PG8_WAIT_V
#undef PG8_WAIT_L
#undef PG8_BAR
#undef PG8_SCHED
}
}
namespace mk {
using pg8::bf16_t; using pg8::bf16x8; using pg8::f32x4; using pg8::u32x4;
#define LAS __attribute__((address_space(3)))
typedef float f32x16 __attribute__((ext_vector_type(16)));
typedef short s16x4 __attribute__((ext_vector_type(4)));
typedef unsigned u32x2 __attribute__((ext_vector_type(2)));
constexpr int SEQ = 8192, DM = 2048, DIN = 5636, LDU = 5632, NBIG = 13824, DFF = 8192, WBR = 512, NH = 4, HD = 128;
constexpr float LOG2E = 1.4426950408889634f;
constexpr float C2 = 0.08838834764831845f * LOG2E;
constexpr float ALPHA = 1.4142135623730951f;
constexpr float LN_EPS = 1e-5f;
constexpr size_t MiB = 1u << 20;
constexpr size_t WS_CTL = 0, WS_WIN = 1 * MiB, WS_WB = 55 * MiB, WS_WO = 63 * MiB, WS_W1 = 71 * MiB, WS_W2 = 103 * MiB, WS_U = 135 * MiB, WS_GH = 223 * MiB,
                 WS_OALL = 351 * MiB, WS_MFY = 383 * MiB, WS_MB = 447 * MiB, WS_XN = 479 * MiB, WS_LF = 511 * MiB, WS_F2 = 511 * MiB + 256 * 1024, WS_PUB = 512 * MiB, WS_END = 513 * MiB;
constexpr int LDS_BYTES = 147456;
constexpr int NUNITS_MIX = 1024 + 3 * 128;

__device__ __forceinline__ unsigned f2bf(float f) { unsigned u = __builtin_bit_cast(unsigned, f); return (u + 0x7fffu + ((u >> 16) & 1u)) >> 16; }
__device__ __forceinline__ unsigned pk2(float lo, float hi) { return f2bf(lo) | (f2bf(hi) << 16); }
__device__ __forceinline__ float bf2f(unsigned short h) { return __uint_as_float((unsigned)h << 16); }
__device__ __forceinline__ float wave_sum(float v) {
#pragma unroll
    for (int o = 1; o < 64; o <<= 1) v += __shfl_xor(v, o);
    return v;
}
#define XB_TMO      128
#define XB_XCNT(j)  (256  + 64 * (j))
#define XB_XSUB(j)  (1280 + 64 * (j))
#define XB_XGEN(j)  (2304 + 64 * (j))
#define XB_TOP      3328
#define XB_TOPGEN   3392
#define XCD_BAR_WORDS 3456
#define XB_SPIN_CAP (1u << 18)

__device__ __forceinline__ unsigned xb_ld(unsigned* p)              { return __hip_atomic_load(p, __ATOMIC_RELAXED, __HIP_MEMORY_SCOPE_AGENT); }
__device__ __forceinline__ unsigned xb_add(unsigned* p, unsigned v) { return __hip_atomic_fetch_add(p, v, __ATOMIC_RELAXED, __HIP_MEMORY_SCOPE_AGENT); }
__device__ __forceinline__ unsigned xb_xcc_id() { return (unsigned)__builtin_amdgcn_s_getreg((3 << 11) | 20) & 0xFu; }
#define XB_SPIN(cond, bar) do { unsigned _sp = 0; while (cond) { __builtin_amdgcn_s_sleep(1); \
    if ((++_sp & 255u) == 0u) { if (xb_ld(&(bar)[XB_TMO])) break; if (_sp > XB_SPIN_CAP) { atomicAdd(&(bar)[XB_TMO], 1u); break; } } } } while (0)

struct XcdBarrier {
    unsigned* bar; unsigned x;
    volatile LAS unsigned* st;
};

__device__ __forceinline__ XcdBarrier xcd_barrier_post(unsigned* bar, volatile LAS unsigned* st) {
    XcdBarrier b; b.bar = bar; b.x = xb_xcc_id(); b.st = st;
    if (threadIdx.x == 0) (void)xb_add(&bar[XB_XCNT(b.x)], 1u);
    return b;
}
__device__ __forceinline__ void xcd_barrier_complete(unsigned* bar, unsigned x, unsigned& nloc, unsigned& nx) {
    const unsigned G = gridDim.x * gridDim.y * gridDim.z;
    unsigned sum, cnt, mine, sp = 0u;
    for (;;) {
        sum = 0u; cnt = 0u; mine = 0u;
#pragma unroll
        for (unsigned j = 0; j < 16; ++j) { const unsigned c = xb_ld(&bar[XB_XCNT(j)]); sum += c; cnt += (c > 0u) ? 1u : 0u; mine = (j == x) ? c : mine; }
        if (sum == G) break;
        __builtin_amdgcn_s_sleep(1);
        if ((++sp & 255u) == 0u) { if (xb_ld(&bar[XB_TMO])) break; if (sp > XB_SPIN_CAP) { atomicAdd(&bar[XB_TMO], 1u); break; } }
    }
    nloc = mine > 0u ? mine : 1u; nx = cnt > 0u ? cnt : 1u;
}

__device__ __forceinline__ void xcd_barrier(const XcdBarrier& b) {
    asm volatile("s_waitcnt vmcnt(0)" ::: "memory");
    __syncthreads();
    if (threadIdx.x == 0) {
        unsigned* bar = b.bar;
        __builtin_amdgcn_s_waitcnt(0);
        unsigned nloc = b.st[0], nx = b.st[1];
        if (nloc == 0u) { xcd_barrier_complete(bar, b.x, nloc, nx); b.st[0] = nloc; b.st[1] = nx; }
        const unsigned old = xb_add(&bar[XB_XSUB(b.x)], 1u);
        const unsigned gen = old / nloc;
        if (old + 1u == (gen + 1u) * nloc) {
            __builtin_amdgcn_fence(__ATOMIC_RELEASE, "agent");
            asm volatile("s_waitcnt vmcnt(0)" ::: "memory");
            const unsigned og = xb_add(&bar[XB_TOP], 1u);
            const unsigned tg = og / nx;
            if (og + 1u == (tg + 1u) * nx) xb_add(&bar[XB_TOPGEN], 1u);
            else XB_SPIN(xb_ld(&bar[XB_TOPGEN]) == tg, bar);
            __builtin_amdgcn_fence(__ATOMIC_ACQUIRE, "agent");
            xb_add(&bar[XB_XGEN(b.x)], 1u);
            asm volatile("s_waitcnt vmcnt(0)" ::: "memory");
        } else {
            XB_SPIN(xb_ld(&bar[XB_XGEN(b.x)]) == gen, bar);
            __builtin_amdgcn_fence(__ATOMIC_ACQUIRE, "agent");
            asm volatile("s_waitcnt vmcnt(0)" ::: "memory");
        }
    }
    __syncthreads();
}


__device__ __forceinline__ float log_sigmoid(float x) { return fminf(x, 0.f) - log1pf(expf(-fabsf(x))); }

__device__ __forceinline__ void transpose_item(const float* __restrict__ W, int ldw, int col0, int k0, bf16_t* __restrict__ WT, int K, int row0, LAS float* scr, int lane) {
#pragma unroll 8
    for (int i = 0; i < 32; ++i) { const int kk = 2 * i + (lane >> 5); scr[kk * 33 + (lane & 31)] = W[(size_t)(k0 + kk) * ldw + col0 + (lane & 31)]; }
    asm volatile("s_waitcnt lgkmcnt(0)" ::: "memory");
    const int c = lane & 7;
#pragma unroll
    for (int j = 0; j < 4; ++j) { const int n = (lane >> 3) + 8 * j; const LAS float* s = scr + (8 * c) * 33 + n;
        u32x4 o; o.x = pk2(s[0 * 33], s[1 * 33]); o.y = pk2(s[2 * 33], s[3 * 33]); o.z = pk2(s[4 * 33], s[5 * 33]); o.w = pk2(s[6 * 33], s[7 * 33]);
        *(u32x4*)(WT + (size_t)(row0 + n) * K + k0 + 8 * c) = o; }
    asm volatile("s_waitcnt lgkmcnt(0)" ::: "memory");
}
struct Ptrs {
    const float *x, *ln_in_g, *ln_in_b, *w_in, *b_forget, *conv_w, *conv_b, *w_r, *b_r, *w_i, *b_i, *lam, *rel_bias, *w_branch, *w_gate, *b_gate, *w_out, *ln1_g, *ln1_b, *w_ff1, *w_ff2, *ln2_g, *ln2_b;
    float* out; unsigned char* ws;
};
struct Args { const float* in[23]; float* out; unsigned char* ws; };
typedef const Args __attribute__((address_space(4))) * KArgP;
__device__ __forceinline__ KArgP kargs() { KArgP p = (KArgP)__builtin_amdgcn_kernarg_segment_ptr(); asm volatile("" : "+s"(p)); return p; }
__device__ __forceinline__ void convert_weights(const Ptrs& P, int l, LAS unsigned char* lds, int gw, int ngw, int wave, int lane) {
    LAS float* scr = (LAS float*)(lds + wave * 16384);
    bf16_t* WIN = (bf16_t*)(P.ws + WS_WIN); bf16_t* WB = (bf16_t*)(P.ws + WS_WB); bf16_t* WO = (bf16_t*)(P.ws + WS_WO); bf16_t* W1 = (bf16_t*)(P.ws + WS_W1); bf16_t* W2 = (bf16_t*)(P.ws + WS_W2);
    constexpr int I_IN = 32 * 176, I_G = 4 * 32 * 64, I_B = 4 * 8 * 64, I_O = 32 * 64, I_1 = 32 * 256, I_2 = 128 * 64, NIT = I_IN + I_G + I_B + I_O + I_1 + I_2;
    for (int it = gw; it < NIT; it += ngw) {
        int r = it;
        if (r < I_IN) { const int kb = r / 176, nb = r % 176, d = 32 * nb; transpose_item(P.w_in + (size_t)l * DM * DIN, DIN, d < 1536 ? d : d + 4, 64 * kb, WIN, DM, d, scr, lane); continue; } r -= I_IN;
        if (r < I_G) { const int g = r / 2048, q = r % 2048, kb = q / 64, nb = q % 64; transpose_item(P.w_gate + (size_t)(l * 4 + g) * DM * DM, DM, 32 * nb, 64 * kb, WIN, DM, LDU + g * 2048 + 32 * nb, scr, lane); continue; } r -= I_G;
        if (r < I_B) { const int g = r / 512, q = r % 512, kb = q / 64, nb = q % 64; transpose_item(P.w_branch + (size_t)(l * 4 + g) * WBR * DM, DM, 32 * nb, 64 * kb, WB + (size_t)g * DM * WBR, WBR, 32 * nb, scr, lane); continue; } r -= I_B;
        if (r < I_O) { const int kb = r / 64, nb = r % 64; transpose_item(P.w_out + (size_t)l * DM * DM, DM, 32 * nb, 64 * kb, WO, DM, 32 * nb, scr, lane); continue; } r -= I_O;
        if (r < I_1) { const int kb = r / 256, nb = r % 256; transpose_item(P.w_ff1 + (size_t)l * DM * DFF, DFF, 32 * nb, 64 * kb, W1, DM, 32 * nb, scr, lane); continue; } r -= I_1;
        { const int kb = r / 64, nb = r % 64; transpose_item(P.w_ff2 + (size_t)l * DFF * DM, DM, 32 * nb, 64 * kb, W2, DFF, 32 * nb, scr, lane); }
    }
}
__device__ __forceinline__ void ln_rows(const float* __restrict__ src, const float* __restrict__ g, const float* __restrict__ b, float* __restrict__ dx, bf16_t* __restrict__ dxn,
                                        const float* __restrict__ wf, const float* __restrict__ bfg, float* __restrict__ lf, int gw, int ngw, int lane) {
    for (int row = gw; row < SEQ; row += ngw) {
        const float* sr = src + (size_t)row * DM + 4 * lane;
        f32x4 v[8]; float s = 0.f;
#pragma unroll
        for (int j = 0; j < 8; ++j) { v[j] = *(const f32x4*)(sr + 256 * j); s += (v[j][0] + v[j][1]) + (v[j][2] + v[j][3]); }
        const float mean = wave_sum(s) * (1.f / DM); float s2 = 0.f;
#pragma unroll
        for (int j = 0; j < 8; ++j) { v[j] = v[j] - mean; s2 += (v[j][0] * v[j][0] + v[j][1] * v[j][1]) + (v[j][2] * v[j][2] + v[j][3] * v[j][3]); }
        const float rstd = 1.0f / sqrtf(wave_sum(s2) * (1.f / DM) + LN_EPS);
        f32x4 dacc = {0.f, 0.f, 0.f, 0.f};
#pragma unroll
        for (int j = 0; j < 8; ++j) { const int c = 4 * lane + 256 * j; const f32x4 gg = *(const f32x4*)(g + c), bb = *(const f32x4*)(b + c);
            const f32x4 y = v[j] * rstd * gg + bb; v[j] = y;
            *(f32x4*)(dx + (size_t)row * DM + c) = y;
            u32x2 o; o.x = pk2(y[0], y[1]); o.y = pk2(y[2], y[3]); *(u32x2*)(dxn + (size_t)row * DM + c) = o; }
        if (wf) {
#pragma unroll
            for (int j = 0; j < 8; ++j) { const float* wp = wf + (size_t)(4 * lane + 256 * j) * DIN;
                const f32x4 w0 = *(const f32x4*)(wp), w1 = *(const f32x4*)(wp + DIN), w2 = *(const f32x4*)(wp + 2 * DIN), w3 = *(const f32x4*)(wp + 3 * DIN);
                dacc += w0 * v[j][0]; dacc += w1 * v[j][1]; dacc += w2 * v[j][2]; dacc += w3 * v[j][3];
                asm volatile("" ::: "memory"); } }
        if (wf) { float d0 = wave_sum(dacc[0]), d1 = wave_sum(dacc[1]), d2 = wave_sum(dacc[2]), d3 = wave_sum(dacc[3]);
            if (lane == 0) { f32x4 o; o[0] = log_sigmoid(d0 + bfg[0]); o[1] = log_sigmoid(d1 + bfg[1]); o[2] = log_sigmoid(d2 + bfg[2]); o[3] = log_sigmoid(d3 + bfg[3]); *(f32x4*)(lf + (size_t)row * 4) = o; } }
    }
}
__device__ __forceinline__ void cumsum_f(const float* lf, float* F2, LAS unsigned char* lds, int tid) {
    LAS f32x4* part = (LAS f32x4*)lds;
    const int lane = tid & 63, wv = tid >> 6;
    f32x4 v[16]; f32x4 s = {0.f, 0.f, 0.f, 0.f};
#pragma unroll
    for (int i = 0; i < 16; ++i) { v[i] = *(const f32x4*)(lf + (size_t)(16 * tid + i) * 4); s += v[i]; }
    f32x4 inc = s;
#pragma unroll
    for (int o = 1; o < 64; o <<= 1) { f32x4 n; n[0] = __shfl_up(inc[0], o); n[1] = __shfl_up(inc[1], o); n[2] = __shfl_up(inc[2], o); n[3] = __shfl_up(inc[3], o); if (lane >= o) inc += n; }
    if (lane == 63) part[wv] = inc;
    __syncthreads();
    f32x4 run = inc - s;
    for (int j = 0; j < wv; ++j) run += part[j];
    f32x4 o0[4], o1[4], o2[4], o3[4];
#pragma unroll
    for (int i = 0; i < 16; ++i) { run += v[i]; o0[i >> 2][i & 3] = run[0] * LOG2E; o1[i >> 2][i & 3] = run[1] * LOG2E; o2[i >> 2][i & 3] = run[2] * LOG2E; o3[i >> 2][i & 3] = run[3] * LOG2E; }
#pragma unroll
    for (int q = 0; q < 4; ++q) { *(f32x4*)(F2 + 0 * SEQ + 16 * tid + 4 * q) = o0[q]; *(f32x4*)(F2 + 1 * SEQ + 16 * tid + 4 * q) = o1[q]; *(f32x4*)(F2 + 2 * SEQ + 16 * tid + 4 * q) = o2[q]; *(f32x4*)(F2 + 3 * SEQ + 16 * tid + 4 * q) = o3[q]; }
    __syncthreads();
}
constexpr int A_K = 0, A_V = 32768, A_F2K = 65536, A_BIAS = 66048, A_FLAGS = 67328, A_UNIT = 67456;
__device__ __forceinline__ int offb(int row, int ch) { return 256 * row + 16 * (ch ^ (((row & 3) << 2) | ((row >> 2) & 3))); }
__device__ __forceinline__ s16x4 vtr(LAS const unsigned char* p) { return __builtin_bit_cast(s16x4, __builtin_amdgcn_ds_read_tr16_b64_v4i16((LAS s16x4*)p)); }
#define MFMA32(a, b, c) __builtin_amdgcn_mfma_f32_32x32x16_bf16((a), (b), (c), 0, 0, 0)
template <int S> __device__ __forceinline__ bf16x8 pack8(const f32x16& x) {
    u32x4 p; p.x = pg8::pk_bf16(x[8 * S], x[8 * S + 1]); p.y = pg8::pk_bf16(x[8 * S + 2], x[8 * S + 3]); p.z = pg8::pk_bf16(x[8 * S + 4], x[8 * S + 5]); p.w = pg8::pk_bf16(x[8 * S + 6], x[8 * S + 7]);
    return __builtin_bit_cast(bf16x8, p);
}
constexpr float FOX_TH2 = 60.0f;
constexpr float SB_RMIN = 1e-20f;

template <int MODE  >
__device__ __forceinline__ void attn_unit(LAS unsigned char* lds, const bf16_t* __restrict__ Qp, const bf16_t* __restrict__ Kp, const bf16_t* __restrict__ Vp, bf16_t* __restrict__ Op,
                                          const int qb, const float* __restrict__ F2h, const float* __restrict__ relb, const float kbnd) {
    const int tid = tid_fresh(), lane = tid & 63, w = __builtin_amdgcn_readfirstlane(tid >> 6), r = lane & 31, hh = lane >> 5;
    const int twmin = qb * 256 + w * 32, twmax = twmin + 31, t = twmin + r;
    bf16x8 qf[8];
    { const bf16_t* qrow = Qp + (size_t)t * LDU + 8 * hh;
#pragma unroll
      for (int kk = 0; kk < 8; ++kk) qf[kk] = *(const bf16x8*)(qrow + 16 * kk); }
    f32x16 O[4];
#pragma unroll
    for (int d = 0; d < 4; ++d)
#pragma unroll
        for (int i = 0; i < 16; ++i) O[d][i] = 0.f;
    float m = -INFINITY, l = 0.f, R = 1.f, f2q = 0.f, qn = 0.f;
    if (MODE == 0) { f2q = F2h[t]; float s = 0.f;
#pragma unroll
        for (int kk = 0; kk < 8; ++kk)
#pragma unroll
            for (int j = 0; j < 8; ++j) { const float v = bf2f((unsigned short)qf[kk][j]); s += v * v; }
        s += __shfl_xor(s, 32); qn = sqrtf(s) * kbnd; }
    LAS float* biasL = (LAS float*)(lds + A_BIAS);
    LAS unsigned* flags = (LAS unsigned*)(lds + A_FLAGS);
    if (MODE == 2) { for (int i = tid; i < 320; i += 512) biasL[i] = relb[i] * LOG2E; }
    const int jhi = 4 * qb + 3, jlo = (MODE == 2) ? (4 * qb - 8 > 0 ? 4 * qb - 8 : 0) : 0;
    const int srow = tid >> 4, sch = tid & 15, soff0 = offb(srow, sch), soff1 = offb(srow + 32, sch);
    const bf16_t* kg = Kp + (size_t)srow * LDU + 8 * sch; const bf16_t* vg = Vp + (size_t)srow * LDU + 8 * sch;
    u32x4 kr0, kr1, vr0, vr1; float f2r = 0.f;
#define A_LOADT(jt) do { const size_t o_ = (size_t)(jt) * 64 * LDU; kr0 = *(const u32x4*)(kg + o_); kr1 = *(const u32x4*)(kg + o_ + 32 * LDU); vr0 = *(const u32x4*)(vg + o_); vr1 = *(const u32x4*)(vg + o_ + 32 * LDU); \
        if (MODE == 0 && tid < 64) f2r = F2h[(jt) * 64 + tid]; } while (0)
#define A_STORET(b) do { *(LAS u32x4*)(lds + A_K + (b) * 16384 + soff0) = kr0; *(LAS u32x4*)(lds + A_K + (b) * 16384 + soff1) = kr1; *(LAS u32x4*)(lds + A_V + (b) * 16384 + soff0) = vr0; *(LAS u32x4*)(lds + A_V + (b) * 16384 + soff1) = vr1; \
        if (MODE == 0 && tid < 64) ((LAS float*)(lds + A_F2K + (b) * 256))[tid] = f2r; } while (0)
    A_LOADT(jhi); A_STORET(0);
    __syncthreads();
    const int xk = ((r & 3) << 2) | ((r >> 2) & 3);
    const int li = lane & 15, tq = li >> 2, tp = li & 3, rh = (lane >> 4) & 1;
    int buf = 0, it = 0; bool wdone = false;
    for (int jt = jhi; jt >= jlo; --jt, ++it) {
        const bool more = jt > jlo;
        if (more) A_LOADT(jt - 1);
        const int kb = jt * 64;
        bool active;
        if (MODE == 0) active = (kb <= twmax) && !wdone;
        else if (MODE == 1) active = (kb < twmax) && !wdone;
        else { const int cw = 4 * qb + (w >> 1); active = (jt <= cw) && (jt >= cw - 8); }
        if (active) {
            LAS const unsigned char* Kb = lds + A_K + buf * 16384; LAS const unsigned char* Vb = lds + A_V + buf * 16384;
            f32x16 X[2];
#pragma unroll
            for (int i = 0; i < 16; ++i) { X[0][i] = 0.f; X[1][i] = 0.f; }
#pragma unroll
            for (int kk = 0; kk < 8; ++kk) { const int o = 256 * r + 16 * ((2 * kk + hh) ^ xk);
                const bf16x8 k0 = *(LAS const bf16x8*)(Kb + o), k1 = *(LAS const bf16x8*)(Kb + o + 8192);
                X[0] = MFMA32(k0, qf[kk], X[0]); X[1] = MFMA32(k1, qf[kk], X[1]); }
            if (MODE == 0 || MODE == 2) {
                float mx = -INFINITY;
                if (MODE == 0) { LAS const float* f2k = (LAS const float*)(lds + A_F2K + buf * 256); const bool needmask = (kb + 63 > twmin);
#pragma unroll
                    for (int b = 0; b < 2; ++b)
#pragma unroll
                        for (int g = 0; g < 4; ++g) { const f32x4 fk = *(LAS const f32x4*)(f2k + 32 * b + 8 * g + 4 * hh);
#pragma unroll
                            for (int c = 0; c < 4; ++c) { float s = X[b][4 * g + c] + (f2q - fk[c]); if (needmask && (kb + 32 * b + 8 * g + 4 * hh + c > t)) s = -INFINITY; X[b][4 * g + c] = s; mx = fmaxf(mx, s); } }
                } else {
#pragma unroll
                    for (int b = 0; b < 2; ++b)
#pragma unroll
                        for (int i = 0; i < 16; ++i) { const int key = kb + 32 * b + 8 * (i >> 2) + 4 * hh + (i & 3); int dist = t - key; dist = dist < -63 ? -63 : (dist > 256 ? 256 : dist);
                            const float s = X[b][i] + biasL[dist + 63]; X[b][i] = s; mx = fmaxf(mx, s); }
                }
                mx = fmaxf(mx, __shfl_xor(mx, 32));
                const float mnew = fmaxf(m, mx), msafe = (mnew == -INFINITY) ? 0.f : mnew;
                const float alpha = __builtin_amdgcn_exp2f(m - msafe);
                float ps = 0.f;
#pragma unroll
                for (int b = 0; b < 2; ++b)
#pragma unroll
                    for (int i = 0; i < 16; ++i) { const float p = __builtin_amdgcn_exp2f(X[b][i] - msafe); X[b][i] = p; ps += p; }
                l = l * alpha + ps; m = mnew;
                if (!__all(alpha == 1.0f)) {
#pragma unroll
                    for (int d = 0; d < 4; ++d)
#pragma unroll
                        for (int i = 0; i < 16; ++i) O[d][i] *= alpha; }
            } else {
                const bool needmask = (kb + 63 >= twmin);
                f32x16 OM[2];
#pragma unroll
                for (int b = 0; b < 2; ++b)
#pragma unroll
                    for (int i = 0; i < 16; ++i) { const float e = __builtin_amdgcn_exp2f(fminf(X[b][i], 115.0f)); float omb = __builtin_amdgcn_rcpf(1.0f + e); float beta = e * omb;
                        if (needmask && (kb + 32 * b + 8 * (i >> 2) + 4 * hh + (i & 3) >= t)) { omb = 1.0f; beta = 0.f; }
                        OM[b][i] = omb; X[b][i] = beta; }
                float Rr = R;
#pragma unroll
                for (int b = 1; b >= 0; --b)
#pragma unroll
                    for (int g = 3; g >= 0; --g) { const float G = (OM[b][4 * g] * OM[b][4 * g + 1]) * (OM[b][4 * g + 2] * OM[b][4 * g + 3]); const float Gp = __shfl_xor(G, 32);
                        const float E = hh ? Rr : Rr * Gp; Rr = Rr * (G * Gp);
                        const float w3 = E, w2 = w3 * OM[b][4 * g + 3], w1 = w2 * OM[b][4 * g + 2], w0 = w1 * OM[b][4 * g + 1];
                        X[b][4 * g + 3] *= w3; X[b][4 * g + 2] *= w2; X[b][4 * g + 1] *= w1; X[b][4 * g] *= w0; }
                R = Rr;
            }
            const bf16x8 p00 = pack8<0>(X[0]), p01 = pack8<1>(X[0]), p10 = pack8<0>(X[1]), p11 = pack8<1>(X[1]);
#pragma unroll
            for (int db = 0; db < 4; ++db) {
#pragma unroll
                for (int bs = 0; bs < 4; ++bs) {
                    s16x4 v[2];
#pragma unroll
                    for (int jj = 0; jj < 2; ++jj) { const int xr = (tq << 2) | (2 * jj + hh); const int ch = (4 * db + 2 * rh + (tp >> 1)) ^ xr;
                        v[jj] = vtr(Vb + 256 * (16 * bs + 8 * jj + 4 * hh + tq) + 16 * ch + 8 * (tp & 1)); }
                    bf16x8 vf; vf[0] = v[0][0]; vf[1] = v[0][1]; vf[2] = v[0][2]; vf[3] = v[0][3]; vf[4] = v[1][0]; vf[5] = v[1][1]; vf[6] = v[1][2]; vf[7] = v[1][3];
                    O[db] = MFMA32(vf, bs == 0 ? p00 : (bs == 1 ? p01 : (bs == 2 ? p10 : p11)), O[db]); } }
            if (MODE == 0) { const float fk0 = ((LAS const float*)(lds + A_F2K + buf * 256))[0]; wdone = __all((qn + f2q - fk0 - m) < -FOX_TH2); }
            if (MODE == 1) wdone = __all(R < SB_RMIN);
        }
        if (more) A_STORET(buf ^ 1);
        if (MODE != 2) { if (lane == 0) flags[(it & 1) * 8 + w] = wdone ? 1u : 0u; }
        __syncthreads();
        if (MODE != 2) { unsigned a = 1u;
#pragma unroll
            for (int i = 0; i < 8; ++i) a &= flags[(it & 1) * 8 + i];
            if (a) break; }
        buf ^= 1;
    }
#undef A_LOADT
#undef A_STORET
    float sc = 1.0f;
    if (MODE != 1) { const float lt = l + __shfl_xor(l, 32); sc = 1.0f / lt; }
    bf16_t* orow = Op + (size_t)t * WBR + 4 * hh;
#pragma unroll
    for (int db = 0; db < 4; ++db)
#pragma unroll
        for (int g = 0; g < 4; ++g) { u32x2 o; o.x = pg8::pk_bf16(O[db][4 * g] * sc, O[db][4 * g + 1] * sc); o.y = pg8::pk_bf16(O[db][4 * g + 2] * sc, O[db][4 * g + 3] * sc);
            *(u32x2*)(orow + 32 * db + 8 * g) = o; }
}
constexpr int L_WR = 0, L_WI = 8704, L_RAW = 17408, L_XC = 50944, L_A = 85760, L_INP = 102144, L_RY = 118528, L_AH = 126720, L_CARRY = 130816, L_PAR = 131072;
__device__ __forceinline__ float gelu_tanh(float y) { const float u = 0.7978845608028654f * (y + 0.044715f * y * y * y); const float th = 1.0f - 2.0f / (1.0f + __expf(2.0f * u)); return 0.5f * y * (1.0f + th); }
typedef __attribute__((address_space(1))) unsigned long long gu64;
__device__ __forceinline__ void lru_unit(LAS unsigned char* lds, const int l, const int n, const int cs, const int sg, const bf16_t* __restrict__ U, bf16_t* __restrict__ Oout, unsigned long long* pub) {
    const int tid = tid_fresh(), lane = tid & 63, w = __builtin_amdgcn_readfirstlane(tid >> 6);
    const int ch0 = n * 128, oc0 = ch0 + 32 * cs, t0 = sg * 128;
    LAS float* par = (LAS float*)(lds + L_PAR);
    LAS float* carry = (LAS float*)(lds + L_CARRY);
    gu64* gran = (gu64*)pub + (size_t)((l * 16 + n * 4 + cs) * 64) * 64;
    {
        KArgP k = kargs(); Ptrs P; P.w_r = k->in[7]; P.b_r = k->in[8]; P.w_i = k->in[9]; P.b_i = k->in[10]; P.lam = k->in[11]; P.conv_w = k->in[5]; P.conv_b = k->in[6];
        const float* wr = P.w_r + (size_t)(l * 4 + n) * 128 * 128; const float* wi = P.w_i + (size_t)(l * 4 + n) * 128 * 128;
        for (int idx = tid; idx < 128 * 32; idx += 512) { const int c = idx >> 5, d = idx & 31;
            *(LAS unsigned short*)(lds + L_WR + d * 272 + 2 * c) = (unsigned short)f2bf(wr[c * 128 + 32 * cs + d]);
            *(LAS unsigned short*)(lds + L_WI + d * 272 + 2 * c) = (unsigned short)f2bf(wi[c * 128 + 32 * cs + d]); }
        if (tid < 32) { par[tid] = 8.0f * log_sigmoid(P.lam[l * 512 + oc0 + tid]); par[32 + tid] = P.b_r[l * 512 + oc0 + tid]; par[64 + tid] = P.b_i[l * 512 + oc0 + tid]; }
        if (tid < 128) { par[96 + tid] = P.conv_b[l * 512 + ch0 + tid];
#pragma unroll
            for (int j = 0; j < 4; ++j) par[224 + j * 128 + tid] = P.conv_w[(size_t)(l * 4 + j) * 512 + ch0 + tid]; }
    }
    {
        const bf16_t* rxg = U + 1536 + ch0; const bf16_t* ryg = U + 2048 + oc0;
#pragma unroll
        for (int i = 0; i < 5; ++i) { const int cidx = tid + 512 * i; const int row = cidx >> 4, ch = cidx & 15; const int tt = t0 - 3 + row;
            u32x4 v = (u32x4){0u, 0u, 0u, 0u}; if (row < 131 && tt >= 0) v = *(const u32x4*)(rxg + (size_t)tt * LDU + 8 * ch);
            if (cidx < 131 * 16) *(LAS u32x4*)(lds + L_RAW + cidx * 16) = v; }
        *(LAS u32x4*)(lds + L_RY + tid * 16) = *(const u32x4*)(ryg + (size_t)(t0 + (tid >> 2)) * LDU + 8 * (tid & 3));
    }
    __syncthreads();
    { const int tok = tid >> 2, qd = tid & 3;
#pragma unroll
      for (int v = 0; v < 4; ++v) { const int c0 = 32 * qd + 8 * v; float xc[8];
#pragma unroll
          for (int e = 0; e < 8; ++e) xc[e] = par[96 + c0 + e];
#pragma unroll
          for (int j = 0; j < 4; ++j) { const u32x4 rw = *(LAS const u32x4*)(lds + L_RAW + (tok + j) * 256 + 2 * c0);
              const unsigned ww[4] = {rw.x, rw.y, rw.z, rw.w};
#pragma unroll
              for (int e = 0; e < 4; ++e) { xc[2 * e] += __uint_as_float(ww[e] << 16) * par[224 + j * 128 + c0 + 2 * e]; xc[2 * e + 1] += __uint_as_float(ww[e] & 0xffff0000u) * par[224 + j * 128 + c0 + 2 * e + 1]; } }
          u32x4 o; o.x = pk2(xc[0], xc[1]); o.y = pk2(xc[2], xc[3]); o.z = pk2(xc[4], xc[5]); o.w = pk2(xc[6], xc[7]);
          *(LAS u32x4*)(lds + L_XC + tok * 272 + 2 * c0) = o; } }
    __syncthreads();
    { const int fr = lane & 15, fq = lane >> 4;
      f32x4 ar[2], ai[2];
#pragma unroll
      for (int ct = 0; ct < 2; ++ct) { ar[ct] = (f32x4){0.f, 0.f, 0.f, 0.f}; ai[ct] = (f32x4){0.f, 0.f, 0.f, 0.f}; }
#pragma unroll
      for (int kk = 0; kk < 4; ++kk) { const bf16x8 a = *(LAS const bf16x8*)(lds + L_XC + (16 * w + fr) * 272 + 2 * (32 * kk + 8 * fq));
#pragma unroll
          for (int ct = 0; ct < 2; ++ct) { const bf16x8 br_ = *(LAS const bf16x8*)(lds + L_WR + (16 * ct + fr) * 272 + 2 * (32 * kk + 8 * fq)); const bf16x8 bi_ = *(LAS const bf16x8*)(lds + L_WI + (16 * ct + fr) * 272 + 2 * (32 * kk + 8 * fq));
              ar[ct] = __builtin_amdgcn_mfma_f32_16x16x32_bf16(a, br_, ar[ct], 0, 0, 0); ai[ct] = __builtin_amdgcn_mfma_f32_16x16x32_bf16(a, bi_, ai[ct], 0, 0, 0); } }
#pragma unroll
      for (int ct = 0; ct < 2; ++ct) { const int d = 16 * ct + fr, c = 32 * cs + d;
#pragma unroll
          for (int rg = 0; rg < 4; ++rg) { const int tt = 16 * w + 4 * fq + rg;
              const float rgate = pg8::sigmoidf_(ar[ct][rg] + par[32 + d]), igate = pg8::sigmoidf_(ai[ct][rg] + par[64 + d]);
              const float la = rgate * par[d]; const float a = __expf(la); const float mult = sqrtf(fmaxf(-expm1f(2.0f * la), 0.f));
              float xcf = par[96 + c];
#pragma unroll
              for (int j = 0; j < 4; ++j) xcf += bf2f(*(LAS const unsigned short*)(lds + L_RAW + (tt + j) * 256 + 2 * c)) * par[224 + j * 128 + c];
              ((LAS float*)(lds + L_A))[tt * 32 + d] = a; ((LAS float*)(lds + L_INP))[tt * 32 + d] = mult * igate * xcf; } } }
    __syncthreads();
    { const int d = tid & 31, sub = tid >> 5;
      LAS const float* Aa = (LAS const float*)(lds + L_A) + (8 * sub) * 32 + d; LAS const float* Ii = (LAS const float*)(lds + L_INP) + (8 * sub) * 32 + d;
      float av[8], iv[8], A = 1.f, H = 0.f;
#pragma unroll
      for (int i = 0; i < 8; ++i) { av[i] = Aa[i * 32]; iv[i] = Ii[i * 32]; H = av[i] * H + iv[i]; A *= av[i]; }
      LAS float* AH = (LAS float*)(lds + L_AH);
      AH[(sub * 32 + d) * 2] = A; AH[(sub * 32 + d) * 2 + 1] = H;
      __syncthreads();
      if (tid < 32) { float As = 1.f, Hs = 0.f;
#pragma unroll
          for (int s = 0; s < 16; ++s) { const float a_ = AH[(s * 32 + tid) * 2], h_ = AH[(s * 32 + tid) * 2 + 1]; Hs = a_ * Hs + h_; As *= a_; }
          __hip_atomic_store(gran + (size_t)sg * 64 + 2 * tid, (1ull << 32) | (unsigned long long)__float_as_uint(As), __ATOMIC_RELAXED, __HIP_MEMORY_SCOPE_AGENT);
          __hip_atomic_store(gran + (size_t)sg * 64 + 2 * tid + 1, (1ull << 32) | (unsigned long long)__float_as_uint(Hs), __ATOMIC_RELAXED, __HIP_MEMORY_SCOPE_AGENT); }
      LAS float* GA = (LAS float*)(lds + L_XC);
      for (int sp = w; sp < sg; sp += 8) { gu64* g = gran + (size_t)sp * 64 + lane; unsigned long long x; unsigned spins = 0;
          for (;;) { x = __hip_atomic_load(g, __ATOMIC_RELAXED, __HIP_MEMORY_SCOPE_AGENT); if (__all((unsigned)(x >> 32) == 1u)) break; if (++spins > (1u << 22)) break; __builtin_amdgcn_s_sleep(2); }
          GA[sp * 64 + lane] = __uint_as_float((unsigned)x); }
      __syncthreads();
      if (tid < 32) { float h = 0.f; for (int sp = 0; sp < sg; ++sp) h = GA[sp * 64 + 2 * tid] * h + GA[sp * 64 + 2 * tid + 1]; carry[tid] = h; }
      __syncthreads();
      float h = carry[d];
      for (int s = 0; s < sub; ++s) h = AH[(s * 32 + d) * 2] * h + AH[(s * 32 + d) * 2 + 1];
#pragma unroll
      for (int i = 0; i < 8; ++i) { h = av[i] * h + iv[i]; const int tt = 8 * sub + i;
          const float y = bf2f(*(LAS const unsigned short*)(lds + L_RY + tt * 64 + 2 * d));
          Oout[(size_t)(t0 + tt) * WBR + oc0 + d] = (unsigned short)f2bf(h * gelu_tanh(y)); } }
    __syncthreads();
}
constexpr int LDS_UNIT = 147392, CW_BAR = 4096;
__device__ __forceinline__ Ptrs make_ptrs(KArgP k) {
    Ptrs P;
    P.x = k->in[0]; P.ln_in_g = k->in[1]; P.ln_in_b = k->in[2]; P.w_in = k->in[3]; P.b_forget = k->in[4]; P.conv_w = k->in[5]; P.conv_b = k->in[6]; P.w_r = k->in[7]; P.b_r = k->in[8]; P.w_i = k->in[9]; P.b_i = k->in[10];
    P.lam = k->in[11]; P.rel_bias = k->in[12]; P.w_branch = k->in[13]; P.w_gate = k->in[14]; P.b_gate = k->in[15]; P.w_out = k->in[16]; P.ln1_g = k->in[17]; P.ln1_b = k->in[18]; P.w_ff1 = k->in[19]; P.w_ff2 = k->in[20];
    P.ln2_g = k->in[21]; P.ln2_b = k->in[22]; P.out = k->out; P.ws = k->ws;
    return P;
}
__global__ void __launch_bounds__(512, 2) fwd_megakernel(Args a_unused) {
    extern __shared__ __attribute__((aligned(16))) unsigned char lds_raw[];
    LAS unsigned char* lds = (LAS unsigned char*)lds_raw;
    cg::grid_group grid = cg::this_grid();
    if (threadIdx.x < 2) ((volatile LAS unsigned*)(lds + LDS_UNIT + 16))[threadIdx.x] = 0u;
    __syncthreads();
    const XcdBarrier bar = xcd_barrier_post((unsigned*)(kargs()->ws + WS_CTL) + CW_BAR, (volatile LAS unsigned*)(lds + LDS_UNIT + 16));
#define MK_IDS() const int tid = tid_fresh(), lane = tid & 63, wave = __builtin_amdgcn_readfirstlane(tid >> 6); const int G = gridDim.x, bx = blockIdx.x; \
    const int vcu = (G % 8 == 0) ? (bx % 8) * (G / 8) + bx / 8 : bx; const int gw = vcu * 8 + wave, ngw = G * 8; (void)lane; (void)gw; (void)ngw; (void)tid;
    { MK_IDS(); KArgP k = kargs(); const Ptrs P = make_ptrs(k);
      ((unsigned long long*)(P.ws + WS_PUB))[(size_t)bx * 512 + tid] = 0ull; if (G < 256) for (int i = G * 512 + bx * 512 + tid; i < 131072; i += G * 512) ((unsigned long long*)(P.ws + WS_PUB))[i] = 0ull;
      convert_weights(P, 0, lds, gw, ngw, wave, lane);
      ln_rows(P.x, P.ln_in_g, P.ln_in_b, P.out, (bf16_t*)(P.ws + WS_XN), P.w_in + 1536, P.b_forget, (float*)(P.ws + WS_LF), gw, ngw, lane); }
    grid.sync();
#pragma unroll 1
    for (int l = 0; l < 2; ++l) {
        { MK_IDS(); KArgP k = kargs(); unsigned char* ws = k->ws;
          if (bx == G - 1) cumsum_f((const float*)(ws + WS_LF), (float*)(ws + WS_F2), lds, tid);
          pg8::Gemm g{(const bf16_t*)(ws + WS_XN), (const bf16_t*)(ws + WS_WIN), SEQ, NBIG, DM}; pg8::StaticOrder S; S.init(SEQ, NBIG, G, bx);
          pg8::EpiIn E{(bf16_t*)(ws + WS_U), (bf16_t*)(ws + WS_GH), k->in[15] + (size_t)l * 4 * DM, (unsigned*)(ws + WS_CTL) + 16 + 16 * l, C2};
          pg8::gemm_phase<pg8::EpiIn, pg8::StaticOrder, true, true>(lds, g, S, E); }
        xcd_barrier(bar);
        { MK_IDS(); KArgP k = kargs(); unsigned char* ws = k->ws; unsigned* ctl = (unsigned*)(ws + WS_CTL);
          const bf16_t* U = (const bf16_t*)(ws + WS_U); bf16_t* OALL = (bf16_t*)(ws + WS_OALL); const float* F2 = (const float*)(ws + WS_F2);
            for (;;) {
                if (tid == 0) *(LAS int*)(lds + LDS_UNIT) = (int)atomicAdd(ctl + l, 1u);
                __syncthreads();
                const int unit = __builtin_amdgcn_readfirstlane(*(LAS int*)(lds + LDS_UNIT));
                __syncthreads();
                if (unit >= NUNITS_MIX) break;
                if (unit < 128) { const int kq = unit, qb = 31 - (kq >> 2), h = kq & 3;
                    float s = 0.f;
#pragma unroll
                    for (int c = 0; c < 4; ++c) s += __uint_as_float(__hip_atomic_load(ctl + 16 + 16 * l + h * 4 + c, __ATOMIC_RELAXED, __HIP_MEMORY_SCOPE_AGENT));
                    attn_unit<0>(lds, U + h * HD, U + 512 + h * HD, U + 1024 + h * HD, OALL + h * HD, qb, F2 + (size_t)h * SEQ, nullptr, sqrtf(s) * 1.02f); }
                else if (unit < 256) { const int kq = unit - 128, qb = kq >> 2, h = kq & 3;
                    attn_unit<2>(lds, U + 4096 + h * HD, U + 4608 + h * HD, U + 5120 + h * HD, OALL + (size_t)3 * SEQ * WBR + h * HD, qb, nullptr, kargs()->in[12] + (size_t)(l * 4 + h) * 320, 0.f); }
                else if (unit < 1280) { const int kq = unit - 256; lru_unit(lds, l, (kq >> 2) & 3, kq & 3, kq >> 4, U, OALL + (size_t)1 * SEQ * WBR, (unsigned long long*)(ws + WS_PUB)); }
                else { const int kq = unit - 1280, qb = kq >> 2, h = kq & 3;
                    attn_unit<1>(lds, U + 2560 + h * HD, U + 3072 + h * HD, U + 3584 + h * HD, OALL + (size_t)2 * SEQ * WBR + h * HD, qb, nullptr, nullptr, 0.f); }
            }
        }
        xcd_barrier(bar);
        { MK_IDS(); KArgP k = kargs(); unsigned char* ws = k->ws;
          pg8::Gemm g{(const bf16_t*)(ws + WS_OALL), (const bf16_t*)(ws + WS_WB), SEQ, DM, WBR}; pg8::BranchOrder S{G, bx};
          pg8::EpiBranch E{(const bf16_t*)(ws + WS_GH), (float*)(ws + WS_MFY), (bf16_t*)(ws + WS_MB)};
          pg8::gemm_phase<pg8::EpiBranch, pg8::BranchOrder, true, true>(lds, g, S, E); }
        xcd_barrier(bar);
        { MK_IDS(); KArgP k = kargs(); unsigned char* ws = k->ws;
          pg8::Gemm g{(const bf16_t*)(ws + WS_MB), (const bf16_t*)(ws + WS_WO), SEQ, DM, DM}; pg8::StaticOrder S; S.init(SEQ, DM, G, bx);
          pg8::EpiResid E{k->out, (float*)(ws + WS_MFY), ALPHA};
          pg8::gemm_phase<pg8::EpiResid, pg8::StaticOrder, true, true>(lds, g, S, E); }
        xcd_barrier(bar);
        { MK_IDS(); KArgP k = kargs(); unsigned char* ws = k->ws;
          ln_rows((const float*)(ws + WS_MFY), k->in[17] + (size_t)l * DM, k->in[18] + (size_t)l * DM, k->out, (bf16_t*)(ws + WS_XN), nullptr, nullptr, nullptr, gw, ngw, lane); }
        xcd_barrier(bar);
        { MK_IDS(); KArgP k = kargs(); unsigned char* ws = k->ws;
          pg8::Gemm g{(const bf16_t*)(ws + WS_XN), (const bf16_t*)(ws + WS_W1), SEQ, DFF, DM}; pg8::StaticOrder S; S.init(SEQ, DFF, G, bx);
          pg8::EpiRelu2 E{(bf16_t*)(ws + WS_GH)};
          pg8::gemm_phase<pg8::EpiRelu2, pg8::StaticOrder, true, true>(lds, g, S, E); }
        xcd_barrier(bar);
        { MK_IDS(); KArgP k = kargs(); unsigned char* ws = k->ws;
          pg8::Gemm g{(const bf16_t*)(ws + WS_GH), (const bf16_t*)(ws + WS_W2), SEQ, DM, DFF}; pg8::StaticOrder S; S.init(SEQ, DM, G, bx);
          pg8::EpiResid E{k->out, (float*)(ws + WS_MFY), ALPHA};
          pg8::gemm_phase<pg8::EpiResid, pg8::StaticOrder, true, true>(lds, g, S, E); }
        xcd_barrier(bar);
        { MK_IDS(); KArgP k = kargs(); const Ptrs P = make_ptrs(k); unsigned char* ws = P.ws;
          if (l == 0) {
            ln_rows((const float*)(ws + WS_MFY), P.ln2_g, P.ln2_b, P.out, (bf16_t*)(ws + WS_XN), P.w_in + (size_t)DM * DIN + 1536, P.b_forget + 4, (float*)(ws + WS_LF), gw, ngw, lane);
            convert_weights(P, 1, lds, gw, ngw, wave, lane);
          } else {
            ln_rows((const float*)(ws + WS_MFY), P.ln2_g + DM, P.ln2_b + DM, P.out, (bf16_t*)(ws + WS_XN), nullptr, nullptr, nullptr, gw, ngw, lane);
          } }
        if (l == 0) xcd_barrier(bar);
    }
}
}

extern "C" void kernel_launch(void* const* d_in, const int* in_sizes, int n_in, void* d_out, int out_size, void* d_ws, size_t ws_size, hipStream_t stream) {
    static int grid = 0;
    if (grid == 0) {
        if (n_in != 23 || out_size != mk::SEQ * mk::DM || ws_size < mk::WS_END) { fprintf(stderr, "kernel_launch: unexpected problem (n_in %d, out %d, ws %zu)\n", n_in, out_size, ws_size); grid = -1; return; }
        int dev = 0, cus = 0, per_cu = 0;
        hipGetDevice(&dev); hipDeviceGetAttribute(&cus, hipDeviceAttributeMultiprocessorCount, dev);
        if (hipFuncSetAttribute((const void*)mk::fwd_megakernel, hipFuncAttributeMaxDynamicSharedMemorySize, mk::LDS_BYTES) != hipSuccess) { fprintf(stderr, "kernel_launch: hipFuncSetAttribute failed\n"); grid = -1; return; }
        if (hipOccupancyMaxActiveBlocksPerMultiprocessor(&per_cu, (const void*)mk::fwd_megakernel, 512, mk::LDS_BYTES) != hipSuccess || per_cu < 1) { fprintf(stderr, "kernel_launch: occupancy query gave %d\n", per_cu); per_cu = 1; (void)hipGetLastError(); }
        grid = cus * per_cu;
    }
    if (grid < 0) return;
    (void)hipMemsetAsync((char*)d_ws + mk::WS_CTL, 0, 65536, stream);
    mk::Args a{};
    for (int i = 0; i < 23; ++i) a.in[i] = (const float*)d_in[i];
    a.out = (float*)d_out; a.ws = (unsigned char*)d_ws;
    void* args[] = {&a};
    hipError_t e = hipLaunchCooperativeKernel((const void*)mk::fwd_megakernel, dim3(grid), dim3(512), args, mk::LDS_BYTES, stream);
    if (e != hipSuccess) fprintf(stderr, "cooperative launch failed: %s (grid %d)\n", hipGetErrorString(e), grid);
}
```

```cpp
#include <hip/hip_runtime.h>
#include <hip/hip_cooperative_groups.h>
#include <cstdio>
#include <cstdint>
namespace cg = cooperative_groups;
__device__ __forceinline__ int tid_fresh() { int t = threadIdx.x; asm volatile("" : "+v"(t)); return t; }
namespace pg8 {
#define PG8_LAS __attribute__((address_space(3)))
typedef unsigned short bf16_t;
typedef short bf16x8 __attribute__((ext_vector_type(8)));
typedef float f32x4 __attribute__((ext_vector_type(4)));
typedef unsigned u32x4 __attribute__((ext_vector_type(4)));
constexpr int BM = 256, BK = 64, HALF = 128, HTB = HALF * BK * 2  , STAGE_BYTES = 8 * HTB, NXCD = 8, WGM = 8;

__host__ __device__ __forceinline__ int lds_byte(int r, int c) { const int st = (r >> 4) * 2 + (c >> 5), rr = r & 15, cc = c & 31, ob = rr * 64 + cc * 2; return st * 1024 + (ob ^ (((ob >> 9) & 1) << 5)); }
__host__ __device__ __forceinline__ void stage_rc(int b, int& R, int& C) { const int st = b / 1024, sb = b % 1024, swz = sb ^ (((sb >> 9) & 1) << 5); R = (st >> 1) * 16 + swz / 64; C = (st & 1) * 32 + (swz % 64) / 2; }
__host__ __device__ __forceinline__ int perm32(int rho) { const int n = rho >> 4, i = rho & 15; return 8 * (i >> 2) + 4 * n + (i & 3); }

struct Unit { int pm, pn; };
struct Gemm { const bf16_t* A; const bf16_t* Bt; int M, N, K; };

struct StaticOrder {
    int nM, nN, nwg, G, c;
    __host__ __device__ void init(int M, int N, int G_, int c_) { nM = M / BM; nN = N / BM; nwg = nM * nN; G = G_; c = c_; }
    __host__ __device__ bool next(int i, Unit& u) const {
        const long L = (long)i * G + c; if (L >= nwg) return false;
        int wgid = (int)L; { const int q = nwg / NXCD, r = nwg % NXCD, xcd = wgid % NXCD, off = wgid / NXCD; wgid = (xcd < r ? xcd * (q + 1) : r * (q + 1) + (xcd - r) * q) + off; }
        const int nig = WGM * nN, gid = wgid / nig, fm = gid * WGM, gsz = (nM - fm) < WGM ? (nM - fm) : WGM;
        u.pm = fm + ((wgid % nig) % gsz); u.pn = (wgid % nig) / gsz; return true;
    }
    __device__ __forceinline__ void a_ready(const Unit&) const {}
    __device__ __forceinline__ void done(const Unit&) const {}
};

__device__ __forceinline__ unsigned cvt_pk_bf16(float lo, float hi) { unsigned r; asm volatile("v_cvt_pk_bf16_f32 %0, %1, %2" : "=v"(r) : "v"(lo), "v"(hi)); return r; }
__device__ __forceinline__ unsigned pk_bf16(float lo, float hi) { typedef float f2 __attribute__((ext_vector_type(2))); typedef __bf16 b2 __attribute__((ext_vector_type(2))); f2 v = {lo, hi}; b2 b = __builtin_convertvector(v, b2); return __builtin_bit_cast(unsigned, b); }
__device__ __forceinline__ float sigmoidf_(float x) { return __builtin_amdgcn_rcpf(1.0f + __builtin_amdgcn_exp2f(-1.4426950408889634f * x)); }
constexpr int LDU_ = 5632, NG_ = 8192;
struct EpiIn {
    static constexpr bool PERM = true, AFTER_DRAIN = false;
    bf16_t* U; bf16_t* G; const float* bgate; unsigned* kc2max; float c2;
    __device__ __forceinline__ void operator()(const f32x4 (&acc)[2][2][4][2], const Unit& u, int wr, int wc, int fr, int fq) const {
        const int row0 = u.pm * BM + wr * 64 + fr;
        if (u.pn < 22) {
            const bool isq = (u.pn < 2) || (u.pn == 10) || (u.pn == 11) || (u.pn == 16) || (u.pn == 17);
            const float sc = isq ? c2 : 1.0f;
            const int col0 = u.pn * BM + wc * 32 + 8 * fq;
#pragma unroll
            for (int ai = 0; ai < 2; ++ai)
#pragma unroll
                for (int m = 0; m < 4; ++m) { bf16_t* rowp = U + (size_t)(row0 + ai * HALF + m * 16) * LDU_ + col0;
#pragma unroll
                    for (int bj = 0; bj < 2; ++bj) { const f32x4 v0 = acc[ai][bj][m][0] * sc, v1 = acc[ai][bj][m][1] * sc; u32x4 w;
                        w.x = pk_bf16(v0[0], v0[1]); w.y = pk_bf16(v0[2], v0[3]); w.z = pk_bf16(v1[0], v1[1]); w.w = pk_bf16(v1[2], v1[3]); *(u32x4*)(rowp + bj * HALF) = w; } }
            if (u.pn == 2 || u.pn == 3) {
#pragma unroll
                for (int bj = 0; bj < 2; ++bj) { float mx = 0.f;
#pragma unroll
                    for (int ai = 0; ai < 2; ++ai)
#pragma unroll
                        for (int m = 0; m < 4; ++m) { const f32x4 a = acc[ai][bj][m][0], b = acc[ai][bj][m][1];
                            float s = (a[0] * a[0] + a[1] * a[1]) + (a[2] * a[2] + a[3] * a[3]) + (b[0] * b[0] + b[1] * b[1]) + (b[2] * b[2] + b[3] * b[3]);
                            s += __shfl_xor(s, 16); s += __shfl_xor(s, 32); mx = fmaxf(mx, s); }
                    mx = fmaxf(mx, __shfl_xor(mx, 1)); mx = fmaxf(mx, __shfl_xor(mx, 2)); mx = fmaxf(mx, __shfl_xor(mx, 4)); mx = fmaxf(mx, __shfl_xor(mx, 8));
                    if (fr == 0 && fq == 0) atomicMax(kc2max + ((u.pn - 2) * 2 + bj) * 4 + wc, __float_as_uint(mx)); }
            }
        } else {
            const int gcol0 = (u.pn - 22) * BM + wc * 32 + 8 * fq;
#pragma unroll
            for (int bj = 0; bj < 2; ++bj) { const f32x4 b0 = *(const f32x4*)(bgate + gcol0 + bj * HALF), b1 = *(const f32x4*)(bgate + gcol0 + bj * HALF + 4);
#pragma unroll
                for (int ai = 0; ai < 2; ++ai)
#pragma unroll
                    for (int m = 0; m < 4; ++m) { const f32x4 v0 = acc[ai][bj][m][0] + b0, v1 = acc[ai][bj][m][1] + b1; u32x4 w;
                        w.x = pk_bf16(sigmoidf_(v0[0]), sigmoidf_(v0[1])); w.y = pk_bf16(sigmoidf_(v0[2]), sigmoidf_(v0[3]));
                        w.z = pk_bf16(sigmoidf_(v1[0]), sigmoidf_(v1[1])); w.w = pk_bf16(sigmoidf_(v1[2]), sigmoidf_(v1[3]));
                        *(u32x4*)(G + (size_t)(row0 + ai * HALF + m * 16) * NG_ + gcol0 + bj * HALF) = w; } }
        }
    }
};
struct EpiBranch {
    static constexpr bool PERM = true, AFTER_DRAIN = false;
    const bf16_t* G; float* MF; bf16_t* MB;
    __device__ __forceinline__ void operator()(const f32x4 (&acc)[2][2][4][2], const Unit& u, int wr, int wc, int fr, int fq) const {
        const int g = u.pm >> 5, pmr = u.pm & 31, pnr = u.pn & 7;
        const int row0 = pmr * BM + wr * 64 + fr, col0 = pnr * BM + wc * 32 + 8 * fq;
#pragma unroll
        for (int ai = 0; ai < 2; ++ai)
#pragma unroll
            for (int m = 0; m < 4; ++m) { const size_t row = (size_t)(row0 + ai * HALF + m * 16);
#pragma unroll
                for (int bj = 0; bj < 2; ++bj) { const int col = col0 + bj * HALF;
                    const u32x4 gw = *(const u32x4*)(G + row * NG_ + g * 2048 + col);
                    f32x4 g0, g1; g0[0] = __uint_as_float(gw.x << 16); g0[1] = __uint_as_float(gw.x & 0xffff0000u); g0[2] = __uint_as_float(gw.y << 16); g0[3] = __uint_as_float(gw.y & 0xffff0000u);
                    g1[0] = __uint_as_float(gw.z << 16); g1[1] = __uint_as_float(gw.z & 0xffff0000u); g1[2] = __uint_as_float(gw.w << 16); g1[3] = __uint_as_float(gw.w & 0xffff0000u);
                    f32x4 v0 = acc[ai][bj][m][0] * g0, v1 = acc[ai][bj][m][1] * g1;
                    bf16_t* mf = (bf16_t*)MF + row * 2048 + col;
                    if (g > 0) { const u32x4 pw = *(const u32x4*)mf;
                        v0[0] += __uint_as_float(pw.x << 16); v0[1] += __uint_as_float(pw.x & 0xffff0000u); v0[2] += __uint_as_float(pw.y << 16); v0[3] += __uint_as_float(pw.y & 0xffff0000u);
                        v1[0] += __uint_as_float(pw.z << 16); v1[1] += __uint_as_float(pw.z & 0xffff0000u); v1[2] += __uint_as_float(pw.w << 16); v1[3] += __uint_as_float(pw.w & 0xffff0000u); }
                    u32x4 w; w.x = pk_bf16(v0[0], v0[1]); w.y = pk_bf16(v0[2], v0[3]); w.z = pk_bf16(v1[0], v1[1]); w.w = pk_bf16(v1[2], v1[3]);
                    if (g < 3) *(u32x4*)mf = w; else *(u32x4*)(MB + row * 2048 + col) = w; } }
    }
};
struct BranchOrder {
    int G, c;
    __device__ bool next(int i, Unit& u) const { const int tile = (i >> 2) * G + c; if (tile >= 256) return false; const int g = i & 3; u.pm = g * 32 + (tile >> 3); u.pn = g * 8 + (tile & 7); return true; }
    __device__ __forceinline__ void a_ready(const Unit&) const {}
    __device__ __forceinline__ void done(const Unit&) const {}
};
struct EpiResid {
    static constexpr bool PERM = false, AFTER_DRAIN = false;
    const float* X; float* Y; float alpha;
    __device__ __forceinline__ void operator()(const f32x4 (&acc)[2][2][4][2], const Unit& u, int wr, int wc, int fr, int fq) const {
        const int row0 = u.pm * BM + wr * 64 + fr, col0 = u.pn * BM + wc * 32 + 4 * fq;
#pragma unroll
        for (int ai = 0; ai < 2; ++ai)
#pragma unroll
            for (int m = 0; m < 4; ++m) { const size_t off = (size_t)(row0 + ai * HALF + m * 16) * 2048 + col0;
#pragma unroll
                for (int bj = 0; bj < 2; ++bj)
#pragma unroll
                    for (int n = 0; n < 2; ++n) { const f32x4 x = *(const f32x4*)(X + off + bj * HALF + n * 16); *(f32x4*)(Y + off + bj * HALF + n * 16) = x * alpha + acc[ai][bj][m][n]; } }
    }
};
struct EpiRelu2 {
    static constexpr bool PERM = true, AFTER_DRAIN = false;
    bf16_t* H;
    __device__ __forceinline__ void operator()(const f32x4 (&acc)[2][2][4][2], const Unit& u, int wr, int wc, int fr, int fq) const {
        const int row0 = u.pm * BM + wr * 64 + fr, col0 = u.pn * BM + wc * 32 + 8 * fq;
#pragma unroll
        for (int ai = 0; ai < 2; ++ai)
#pragma unroll
            for (int m = 0; m < 4; ++m) { bf16_t* rowp = H + (size_t)(row0 + ai * HALF + m * 16) * 8192 + col0;
#pragma unroll
                for (int bj = 0; bj < 2; ++bj) { f32x4 v0 = acc[ai][bj][m][0], v1 = acc[ai][bj][m][1];
#pragma unroll
                    for (int e = 0; e < 4; ++e) { const float a = fmaxf(v0[e], 0.f), b = fmaxf(v1[e], 0.f); v0[e] = a * a; v1[e] = b * b; }
                    u32x4 w; w.x = pk_bf16(v0[0], v0[1]); w.y = pk_bf16(v0[2], v0[3]); w.z = pk_bf16(v1[0], v1[1]); w.w = pk_bf16(v1[2], v1[3]); *(u32x4*)(rowp + bj * HALF) = w; } }
    }
};

template <class Epi, class Sched, bool ALIGN_EPI = false, bool SP2 = false>
__device__ __forceinline__ void gemm_phase(PG8_LAS unsigned char* lds, const Gemm g, const Sched& S, const Epi& E) {
    const int tid = tid_fresh(), wid = __builtin_amdgcn_readfirstlane(tid >> 6), lane = tid & 63, wr = wid >> 2, wc = wid & 3, fr = lane & 15, fq = lane >> 4;
    const int K = g.K, nt = K / BK;
    unsigned voffA[2], voffB[2];
#pragma unroll
    for (int i = 0; i < 2; ++i) { int R, C; stage_rc(tid * 16 + i * 8192, R, C); const int Rb = Epi::PERM ? ((R & ~31) + perm32(R & 31)) : R;
        voffA[i] = (unsigned)(R * K + C) * 2u; voffB[i] = (unsigned)(Rb * K + C) * 2u; }
    const size_t kstep = (size_t)(BK * 2);
    const size_t hstep = (size_t)HALF * K * 2;
    const size_t tstep = 2 * hstep;
    const unsigned ldsw = (unsigned)wid * 1024u;
    const int aoff = lds_byte(wr * 64 + fr, fq * 8), boff = lds_byte(wc * 32 + fr, fq * 8);
#define PG8_SA(b, h) (((b) * 2 + (h)) * HTB)
#define PG8_SB(b, h) ((4 + (b) * 2 + (h)) * HTB)
#define PG8_STAGE(bufoff, gbase, voff) do { _Pragma("unroll") for (int _i = 0; _i < 2; ++_i) \
        __builtin_amdgcn_global_load_lds((const unsigned*)((const char*)(gbase) + (voff)[_i]), (PG8_LAS unsigned*)(lds + (bufoff) + ldsw + _i * 8192), 16, 0, 0); } while (0)
#define PG8_LDA(dst, b, h) do { _Pragma("unroll") for (int m = 0; m < 4; ++m) _Pragma("unroll") for (int k = 0; k < 2; ++k) dst[m][k] = *(const PG8_LAS bf16x8*)(lds + PG8_SA(b, h) + aoff + m * 2048 + k * 1024); } while (0)
#define PG8_LDB(dst, b, h) do { _Pragma("unroll") for (int n = 0; n < 2; ++n) _Pragma("unroll") for (int k = 0; k < 2; ++k) dst[n][k] = *(const PG8_LAS bf16x8*)(lds + PG8_SB(b, h) + boff + n * 2048 + k * 1024); } while (0)
#define PG8_MMA(ai, bj, At, Bt) do { __builtin_amdgcn_s_setprio(1); _Pragma("unroll") for (int m = 0; m < 4; ++m) _Pragma("unroll") for (int n = 0; n < 2; ++n) _Pragma("unroll") for (int k = 0; k < 2; ++k) \
        acc[ai][bj][m][n] = __builtin_amdgcn_mfma_f32_16x16x32_bf16(Bt[n][k], At[m][k], acc[ai][bj][m][n], 0, 0, 0); __builtin_amdgcn_s_setprio(0); } while (0)
#define PG8_WAIT_V(n) asm volatile("s_waitcnt vmcnt(" #n ")" ::: "memory")
#define PG8_WAIT_L(n) asm volatile("s_waitcnt lgkmcnt(" #n ")" ::: "memory")
#define PG8_BAR __builtin_amdgcn_s_barrier()
#define PG8_SCHED __builtin_amdgcn_sched_barrier(0)
    Unit cur, nxt; int ui = 0;
    if (!S.next(0, cur)) return;
    f32x4 acc[2][2][4][2];
#pragma unroll
    for (int a = 0; a < 2; ++a)
#pragma unroll
        for (int b = 0; b < 2; ++b)
#pragma unroll
            for (int m = 0; m < 4; ++m)
#pragma unroll
                for (int n = 0; n < 2; ++n) acc[a][b][m][n] = (f32x4){0.f, 0.f, 0.f, 0.f};
    bf16x8 At[4][2], B0[2][2], B1[2][2];
    const char* cA = (const char*)g.A + (size_t)cur.pm * tstep; const char* cB = (const char*)g.Bt + (size_t)cur.pn * tstep;
    S.a_ready(cur);
    if constexpr (SP2) {
        PG8_STAGE(PG8_SB(0, 0), cB, voffB); PG8_STAGE(PG8_SB(0, 1), cB + hstep, voffB); PG8_STAGE(PG8_SA(0, 0), cA, voffA); PG8_STAGE(PG8_SA(0, 1), cA + hstep, voffA);
        if (wr == 1) PG8_BAR;
        PG8_WAIT_V(2); PG8_BAR;
        PG8_STAGE(PG8_SB(1, 0), cB + kstep, voffB); PG8_STAGE(PG8_SA(1, 0), cA + kstep, voffA); PG8_STAGE(PG8_SB(1, 1), cB + hstep + kstep, voffB);
        PG8_WAIT_V(6); PG8_BAR;
    } else {
        PG8_STAGE(PG8_SB(0, 0), cB, voffB); PG8_STAGE(PG8_SA(0, 0), cA, voffA); PG8_STAGE(PG8_SB(0, 1), cB + hstep, voffB); PG8_STAGE(PG8_SA(0, 1), cA + hstep, voffA);
        if (wr == 1) PG8_BAR;
        PG8_WAIT_V(4); PG8_BAR;
        PG8_STAGE(PG8_SB(1, 0), cB + kstep, voffB); PG8_STAGE(PG8_SA(1, 0), cA + kstep, voffA); PG8_STAGE(PG8_SB(1, 1), cB + hstep + kstep, voffB);
        PG8_WAIT_V(6); PG8_BAR;
    }
    for (;;) {
        const bool has_next = S.next(ui + 1, nxt);
        const char* nA = has_next ? (const char*)g.A + (size_t)nxt.pm * tstep : cA; const char* nB = has_next ? (const char*)g.Bt + (size_t)nxt.pn * tstep : cB;
        for (int t = 0; t < nt; t += 2) {
            const bool last = (t == nt - 2);
            const char* a1 = cA + (size_t)(t + 1) * kstep;
            const char* a2 = last ? nA : cA + (size_t)(t + 2) * kstep; const char* b2 = last ? nB : cB + (size_t)(t + 2) * kstep;
            const char* a3 = a2 + kstep; const char* b3 = b2 + kstep;
            if (last && has_next) S.a_ready(nxt);
            if constexpr (SP2) {
            PG8_LDB(B0, 0, 0); PG8_LDB(B1, 0, 1); PG8_SCHED; PG8_LDA(At, 0, 0); PG8_STAGE(PG8_SA(1, 1), a1 + hstep, voffA);
            PG8_WAIT_V(8); PG8_WAIT_L(0); PG8_BAR; PG8_MMA(0, 0, At, B0); PG8_MMA(0, 1, At, B1); PG8_BAR; PG8_SCHED;
            PG8_LDA(At, 0, 1); PG8_STAGE(PG8_SB(0, 0), b2, voffB); PG8_STAGE(PG8_SB(0, 1), b2 + hstep, voffB); PG8_STAGE(PG8_SA(0, 0), a2, voffA);
            PG8_WAIT_V(8); PG8_WAIT_L(0); PG8_BAR; PG8_MMA(1, 0, At, B0); PG8_MMA(1, 1, At, B1); PG8_BAR; PG8_SCHED;
            PG8_LDB(B0, 1, 0); PG8_LDB(B1, 1, 1); PG8_SCHED; PG8_LDA(At, 1, 0); PG8_STAGE(PG8_SA(0, 1), a2 + hstep, voffA);
            PG8_WAIT_V(8); PG8_WAIT_L(0); PG8_BAR; PG8_MMA(0, 0, At, B0); PG8_MMA(0, 1, At, B1); PG8_BAR; PG8_SCHED;
            PG8_LDA(At, 1, 1); PG8_STAGE(PG8_SB(1, 0), b3, voffB); PG8_STAGE(PG8_SB(1, 1), b3 + hstep, voffB); PG8_STAGE(PG8_SA(1, 0), a3, voffA);
            PG8_WAIT_V(8); PG8_WAIT_L(0); PG8_BAR; PG8_MMA(1, 0, At, B0); PG8_MMA(1, 1, At, B1); PG8_BAR; PG8_SCHED;
            } else {
            PG8_LDB(B0, 0, 0); PG8_SCHED; PG8_LDA(At, 0, 0); PG8_STAGE(PG8_SA(1, 1), a1 + hstep, voffA);
            PG8_WAIT_L(8); PG8_BAR; PG8_WAIT_L(0); PG8_MMA(0, 0, At, B0); PG8_BAR; PG8_SCHED;
            PG8_LDB(B1, 0, 1); PG8_STAGE(PG8_SB(0, 0), b2, voffB);
            PG8_BAR; PG8_WAIT_L(0); PG8_MMA(0, 1, At, B1); PG8_BAR;
            PG8_LDA(At, 0, 1); PG8_STAGE(PG8_SA(0, 0), a2, voffA);
            PG8_BAR; PG8_WAIT_L(0); PG8_MMA(1, 0, At, B0); PG8_BAR; PG8_SCHED;
            PG8_STAGE(PG8_SB(0, 1), b2 + hstep, voffB);
            PG8_WAIT_V(6); PG8_BAR; PG8_MMA(1, 1, At, B1); PG8_BAR;
            PG8_LDB(B0, 1, 0); PG8_SCHED; PG8_LDA(At, 1, 0); PG8_STAGE(PG8_SA(0, 1), a2 + hstep, voffA);
            PG8_WAIT_L(8); PG8_BAR; PG8_WAIT_L(0); PG8_MMA(0, 0, At, B0); PG8_BAR; PG8_SCHED;
            PG8_LDB(B1, 1, 1); PG8_STAGE(PG8_SB(1, 0), b3, voffB);
            PG8_BAR; PG8_WAIT_L(0); PG8_MMA(0, 1, At, B1); PG8_BAR;
            PG8_LDA(At, 1, 1); PG8_STAGE(PG8_SA(1, 0), a3, voffA);
            PG8_BAR; PG8_WAIT_L(0); PG8_MMA(1, 0, At, B0); PG8_BAR; PG8_SCHED;
            PG8_STAGE(PG8_SB(1, 1), b3 + hstep, voffB);
            PG8_WAIT_V(6); PG8_BAR; PG8_MMA(1, 1, At, B1); PG8_BAR;
            }
        }
        if constexpr (ALIGN_EPI) { if (wr == 0) PG8_BAR; }
        if constexpr (!Epi::AFTER_DRAIN) { E(acc, cur, wr, wc, fr, fq); S.done(cur); }
        if (!has_next) break;
#pragma unroll
        for (int a = 0; a < 2; ++a)
#pragma unroll
            for (int b = 0; b < 2; ++b)
#pragma unroll
                for (int m = 0; m < 4; ++m)
#pragma unroll
                    for (int n = 0; n < 2; ++n) acc[a][b][m][n] = (f32x4){0.f, 0.f, 0.f, 0.f};
        cur = nxt; cA = nA; cB = nB; ++ui;
        if constexpr (ALIGN_EPI) { if (wr == 1) PG8_BAR; }
    }
    PG8_WAIT_V(0);
    if constexpr (!ALIGN_EPI) { if (wr == 0) PG8_BAR; }
    PG8_BAR;
    if constexpr (Epi::AFTER_DRAIN) { E.fused(acc, cur, wr, wc, fr, fq, lds, wid, lane); S.done(cur); }
#undef PG8_SA
#undef PG8_SB
#undef PG8_STAGE
#undef PG8_LDA
#undef PG8_LDB
#undef PG8_MMA
#undef PG8_WAIT_V
#undef PG8_WAIT_L
#undef PG8_BAR
#undef PG8_SCHED
}
}
namespace mk {
using pg8::bf16_t; using pg8::bf16x8; using pg8::f32x4; using pg8::u32x4;
#define LAS __attribute__((address_space(3)))
typedef float f32x16 __attribute__((ext_vector_type(16)));
typedef short s16x4 __attribute__((ext_vector_type(4)));
typedef unsigned u32x2 __attribute__((ext_vector_type(2)));
constexpr int SEQ = 8192, DM = 2048, DIN = 5636, LDU = 5632, NBIG = 13824, DFF = 8192, WBR = 512, NH = 4, HD = 128;
constexpr float LOG2E = 1.4426950408889634f;
constexpr float C2 = 0.08838834764831845f * LOG2E;
constexpr float ALPHA = 1.4142135623730951f;
constexpr float LN_EPS = 1e-5f;
constexpr size_t MiB = 1u << 20;
constexpr size_t WS_CTL = 0, WS_WIN = 1 * MiB, WS_WB = 55 * MiB, WS_WO = 63 * MiB, WS_W1 = 71 * MiB, WS_W2 = 103 * MiB, WS_U = 135 * MiB, WS_GH = 223 * MiB,
                 WS_OALL = 351 * MiB, WS_MFY = 383 * MiB, WS_MB = 447 * MiB, WS_XN = 479 * MiB, WS_LF = 511 * MiB, WS_F2 = 511 * MiB + 256 * 1024, WS_PUB = 512 * MiB, WS_END = 513 * MiB;
constexpr int LDS_BYTES = 147456;
constexpr int NUNITS_MIX = 1024 + 3 * 128;

__device__ __forceinline__ unsigned f2bf(float f) { unsigned u = __builtin_bit_cast(unsigned, f); return (u + 0x7fffu + ((u >> 16) & 1u)) >> 16; }
__device__ __forceinline__ unsigned pk2(float lo, float hi) { return f2bf(lo) | (f2bf(hi) << 16); }
__device__ __forceinline__ float bf2f(unsigned short h) { return __uint_as_float((unsigned)h << 16); }
__device__ __forceinline__ float wave_sum(float v) {
#pragma unroll
    for (int o = 1; o < 64; o <<= 1) v += __shfl_xor(v, o);
    return v;
}
#define XB_TMO      128
#define XB_XCNT(j)  (256  + 64 * (j))
#define XB_XSUB(j)  (1280 + 64 * (j))
#define XB_XGEN(j)  (2304 + 64 * (j))
#define XB_TOP      3328
#define XB_TOPGEN   3392
#define XCD_BAR_WORDS 3456
#define XB_SPIN_CAP (1u << 18)

__device__ __forceinline__ unsigned xb_ld(unsigned* p)              { return __hip_atomic_load(p, __ATOMIC_RELAXED, __HIP_MEMORY_SCOPE_AGENT); }
__device__ __forceinline__ unsigned xb_add(unsigned* p, unsigned v) { return __hip_atomic_fetch_add(p, v, __ATOMIC_RELAXED, __HIP_MEMORY_SCOPE_AGENT); }
__device__ __forceinline__ unsigned xb_xcc_id() { return (unsigned)__builtin_amdgcn_s_getreg((3 << 11) | 20) & 0xFu; }
#define XB_SPIN(cond, bar) do { unsigned _sp = 0; while (cond) { __builtin_amdgcn_s_sleep(1); \
    if ((++_sp & 255u) == 0u) { if (xb_ld(&(bar)[XB_TMO])) break; if (_sp > XB_SPIN_CAP) { atomicAdd(&(bar)[XB_TMO], 1u); break; } } } } while (0)

struct XcdBarrier {
    unsigned* bar; unsigned x;
    volatile LAS unsigned* st;
};

__device__ __forceinline__ XcdBarrier xcd_barrier_post(unsigned* bar, volatile LAS unsigned* st) {
    XcdBarrier b; b.bar = bar; b.x = xb_xcc_id(); b.st = st;
    if (threadIdx.x == 0) (void)xb_add(&bar[XB_XCNT(b.x)], 1u);
    return b;
}
__device__ __forceinline__ void xcd_barrier_complete(unsigned* bar, unsigned x, unsigned& nloc, unsigned& nx) {
    const unsigned G = gridDim.x * gridDim.y * gridDim.z;
    unsigned sum, cnt, mine, sp = 0u;
    for (;;) {
        sum = 0u; cnt = 0u; mine = 0u;
#pragma unroll
        for (unsigned j = 0; j < 16; ++j) { const unsigned c = xb_ld(&bar[XB_XCNT(j)]); sum += c; cnt += (c > 0u) ? 1u : 0u; mine = (j == x) ? c : mine; }
        if (sum == G) break;
        __builtin_amdgcn_s_sleep(1);
        if ((++sp & 255u) == 0u) { if (xb_ld(&bar[XB_TMO])) break; if (sp > XB_SPIN_CAP) { atomicAdd(&bar[XB_TMO], 1u); break; } }
    }
    nloc = mine > 0u ? mine : 1u; nx = cnt > 0u ? cnt : 1u;
}

__device__ __forceinline__ void xcd_barrier(const XcdBarrier& b) {
    asm volatile("s_waitcnt vmcnt(0)" ::: "memory");
    __syncthreads();
    if (threadIdx.x == 0) {
        unsigned* bar = b.bar;
        __builtin_amdgcn_s_waitcnt(0);
        unsigned nloc = b.st[0], nx = b.st[1];
        if (nloc == 0u) { xcd_barrier_complete(bar, b.x, nloc, nx); b.st[0] = nloc; b.st[1] = nx; }
        const unsigned old = xb_add(&bar[XB_XSUB(b.x)], 1u);
        const unsigned gen = old / nloc;
        if (old + 1u == (gen + 1u) * nloc) {
            __builtin_amdgcn_fence(__ATOMIC_RELEASE, "agent");
            asm volatile("s_waitcnt vmcnt(0)" ::: "memory");
            const unsigned og = xb_add(&bar[XB_TOP], 1u);
            const unsigned tg = og / nx;
            if (og + 1u == (tg + 1u) * nx) xb_add(&bar[XB_TOPGEN], 1u);
            else XB_SPIN(xb_ld(&bar[XB_TOPGEN]) == tg, bar);
            __builtin_amdgcn_fence(__ATOMIC_ACQUIRE, "agent");
            xb_add(&bar[XB_XGEN(b.x)], 1u);
            asm volatile("s_waitcnt vmcnt(0)" ::: "memory");
        } else {
            XB_SPIN(xb_ld(&bar[XB_XGEN(b.x)]) == gen, bar);
            __builtin_amdgcn_fence(__ATOMIC_ACQUIRE, "agent");
            asm volatile("s_waitcnt vmcnt(0)" ::: "memory");
        }
    }
    __syncthreads();
}


__device__ __forceinline__ float log_sigmoid(float x) { return fminf(x, 0.f) - log1pf(expf(-fabsf(x))); }

struct TrItem { const float* src; bf16_t* dst; int ldw, K; };
__device__ __forceinline__ void tr_load(const TrItem& it, float (&v)[32], int lane) {
#pragma unroll
    for (int i = 0; i < 32; ++i) v[i] = it.src[(size_t)(2 * i + (lane >> 5)) * it.ldw + (lane & 31)];
}
__device__ __forceinline__ void tr_finish(const TrItem& it, const float (&v)[32], LAS float* scr, int lane) {
#pragma unroll
    for (int i = 0; i < 32; ++i) scr[(2 * i + (lane >> 5)) * 33 + (lane & 31)] = v[i];
    asm volatile("s_waitcnt lgkmcnt(0)" ::: "memory");
    const int c = lane & 7;
#pragma unroll
    for (int j = 0; j < 4; ++j) { const int n = (lane >> 3) + 8 * j; const LAS float* s = scr + (8 * c) * 33 + n;
        u32x4 o; o.x = pk2(s[0 * 33], s[1 * 33]); o.y = pk2(s[2 * 33], s[3 * 33]); o.z = pk2(s[4 * 33], s[5 * 33]); o.w = pk2(s[6 * 33], s[7 * 33]);
        *(u32x4*)(it.dst + (size_t)n * it.K + 8 * c) = o; }
    asm volatile("s_waitcnt lgkmcnt(0)" ::: "memory");
}
struct Ptrs {
    const float *x, *ln_in_g, *ln_in_b, *w_in, *b_forget, *conv_w, *conv_b, *w_r, *b_r, *w_i, *b_i, *lam, *rel_bias, *w_branch, *w_gate, *b_gate, *w_out, *ln1_g, *ln1_b, *w_ff1, *w_ff2, *ln2_g, *ln2_b;
    float* out; unsigned char* ws;
};
struct Args { const float* in[23]; float* out; unsigned char* ws; };
typedef const Args __attribute__((address_space(4))) * KArgP;
__device__ __forceinline__ KArgP kargs() { KArgP p = (KArgP)__builtin_amdgcn_kernarg_segment_ptr(); asm volatile("" : "+s"(p)); return p; }
__device__ __forceinline__ TrItem tr_decode(const Ptrs& P, int l, int r) {
    bf16_t* WIN = (bf16_t*)(P.ws + WS_WIN); bf16_t* WB = (bf16_t*)(P.ws + WS_WB); bf16_t* WO = (bf16_t*)(P.ws + WS_WO); bf16_t* W1 = (bf16_t*)(P.ws + WS_W1); bf16_t* W2 = (bf16_t*)(P.ws + WS_W2);
    constexpr int I_IN = 32 * 176, I_G = 4 * 32 * 64, I_B = 4 * 8 * 64, I_O = 32 * 64, I_1 = 32 * 256;
    TrItem it;
    if (r < I_IN) { const int kb = r / 176, nb = r % 176, d = 32 * nb; it.ldw = DIN; it.K = DM; it.src = P.w_in + (size_t)l * DM * DIN + (size_t)(64 * kb) * DIN + (d < 1536 ? d : d + 4); it.dst = WIN + (size_t)d * DM + 64 * kb; return it; } r -= I_IN;
    if (r < I_G) { const int g = r / 2048, q = r % 2048, kb = q / 64, nb = q % 64; it.ldw = DM; it.K = DM; it.src = P.w_gate + (size_t)(l * 4 + g) * DM * DM + (size_t)(64 * kb) * DM + 32 * nb; it.dst = WIN + (size_t)(LDU + g * 2048 + 32 * nb) * DM + 64 * kb; return it; } r -= I_G;
    if (r < I_B) { const int g = r / 512, q = r % 512, kb = q / 64, nb = q % 64; it.ldw = DM; it.K = WBR; it.src = P.w_branch + (size_t)(l * 4 + g) * WBR * DM + (size_t)(64 * kb) * DM + 32 * nb; it.dst = WB + (size_t)g * DM * WBR + (size_t)(32 * nb) * WBR + 64 * kb; return it; } r -= I_B;
    if (r < I_O) { const int kb = r / 64, nb = r % 64; it.ldw = DM; it.K = DM; it.src = P.w_out + (size_t)l * DM * DM + (size_t)(64 * kb) * DM + 32 * nb; it.dst = WO + (size_t)(32 * nb) * DM + 64 * kb; return it; } r -= I_O;
    if (r < I_1) { const int kb = r / 256, nb = r % 256; it.ldw = DFF; it.K = DM; it.src = P.w_ff1 + (size_t)l * DM * DFF + (size_t)(64 * kb) * DFF + 32 * nb; it.dst = W1 + (size_t)(32 * nb) * DM + 64 * kb; return it; } r -= I_1;
    { const int kb = r / 64, nb = r % 64; it.ldw = DM; it.K = DFF; it.src = P.w_ff2 + (size_t)l * DFF * DM + (size_t)(64 * kb) * DM + 32 * nb; it.dst = W2 + (size_t)(32 * nb) * DFF + 64 * kb; return it; }
}
__device__ __forceinline__ void convert_weights(const Ptrs& P, int l, LAS unsigned char* lds, int gw, int ngw, int wave, int lane) {
    LAS float* scr0 = (LAS float*)(lds + wave * 17408); LAS float* scr1 = scr0 + 2176;
    constexpr int NIT = 32 * 176 + 4 * 32 * 64 + 4 * 8 * 64 + 32 * 64 + 32 * 256 + 128 * 64;
    for (int it = gw; it < NIT; it += 2 * ngw) {
        const bool two = (it + ngw) < NIT;
        const TrItem a = tr_decode(P, l, it); const TrItem b = tr_decode(P, l, two ? it + ngw : it);
        float va[32], vb[32];
        tr_load(a, va, lane); if (two) tr_load(b, vb, lane);
        tr_finish(a, va, scr0, lane); if (two) tr_finish(b, vb, scr1, lane);
    }
}
__device__ __forceinline__ void ln_rows(const float* __restrict__ src, const float* __restrict__ g, const float* __restrict__ b, float* __restrict__ dx, bf16_t* __restrict__ dxn,
                                        const float* __restrict__ wf, const float* __restrict__ bfg, float* __restrict__ lf, int gw, int ngw, int lane) {
    for (int row = gw; row < SEQ; row += ngw) {
        const float* sr = src + (size_t)row * DM + 4 * lane;
        f32x4 v[8]; float s = 0.f;
#pragma unroll
        for (int j = 0; j < 8; ++j) { v[j] = *(const f32x4*)(sr + 256 * j); s += (v[j][0] + v[j][1]) + (v[j][2] + v[j][3]); }
        const float mean = wave_sum(s) * (1.f / DM); float s2 = 0.f;
#pragma unroll
        for (int j = 0; j < 8; ++j) { v[j] = v[j] - mean; s2 += (v[j][0] * v[j][0] + v[j][1] * v[j][1]) + (v[j][2] * v[j][2] + v[j][3] * v[j][3]); }
        const float rstd = 1.0f / sqrtf(wave_sum(s2) * (1.f / DM) + LN_EPS);
        f32x4 dacc = {0.f, 0.f, 0.f, 0.f};
#pragma unroll
        for (int j = 0; j < 8; ++j) { const int c = 4 * lane + 256 * j; const f32x4 gg = *(const f32x4*)(g + c), bb = *(const f32x4*)(b + c);
            const f32x4 y = v[j] * rstd * gg + bb; v[j] = y;
            *(f32x4*)(dx + (size_t)row * DM + c) = y;
            u32x2 o; o.x = pk2(y[0], y[1]); o.y = pk2(y[2], y[3]); *(u32x2*)(dxn + (size_t)row * DM + c) = o; }
        if (wf) {
#pragma unroll
            for (int j = 0; j < 8; ++j) { const float* wp = wf + (size_t)(4 * lane + 256 * j) * DIN;
                const f32x4 w0 = *(const f32x4*)(wp), w1 = *(const f32x4*)(wp + DIN), w2 = *(const f32x4*)(wp + 2 * DIN), w3 = *(const f32x4*)(wp + 3 * DIN);
                dacc += w0 * v[j][0]; dacc += w1 * v[j][1]; dacc += w2 * v[j][2]; dacc += w3 * v[j][3];
                asm volatile("" ::: "memory"); } }
        if (wf) { float d0 = wave_sum(dacc[0]), d1 = wave_sum(dacc[1]), d2 = wave_sum(dacc[2]), d3 = wave_sum(dacc[3]);
            if (lane == 0) { f32x4 o; o[0] = log_sigmoid(d0 + bfg[0]); o[1] = log_sigmoid(d1 + bfg[1]); o[2] = log_sigmoid(d2 + bfg[2]); o[3] = log_sigmoid(d3 + bfg[3]); *(f32x4*)(lf + (size_t)row * 4) = o; } }
    }
}
__device__ __forceinline__ void cumsum_f(const float* lf, float* F2, LAS unsigned char* lds, int tid) {
    LAS f32x4* part = (LAS f32x4*)lds;
    const int lane = tid & 63, wv = tid >> 6;
    f32x4 v[16]; f32x4 s = {0.f, 0.f, 0.f, 0.f};
#pragma unroll
    for (int i = 0; i < 16; ++i) { v[i] = *(const f32x4*)(lf + (size_t)(16 * tid + i) * 4); s += v[i]; }
    f32x4 inc = s;
#pragma unroll
    for (int o = 1; o < 64; o <<= 1) { f32x4 n; n[0] = __shfl_up(inc[0], o); n[1] = __shfl_up(inc[1], o); n[2] = __shfl_up(inc[2], o); n[3] = __shfl_up(inc[3], o); if (lane >= o) inc += n; }
    if (lane == 63) part[wv] = inc;
    __syncthreads();
    f32x4 run = inc - s;
    for (int j = 0; j < wv; ++j) run += part[j];
    f32x4 o0[4], o1[4], o2[4], o3[4];
#pragma unroll
    for (int i = 0; i < 16; ++i) { run += v[i]; o0[i >> 2][i & 3] = run[0] * LOG2E; o1[i >> 2][i & 3] = run[1] * LOG2E; o2[i >> 2][i & 3] = run[2] * LOG2E; o3[i >> 2][i & 3] = run[3] * LOG2E; }
#pragma unroll
    for (int q = 0; q < 4; ++q) { *(f32x4*)(F2 + 0 * SEQ + 16 * tid + 4 * q) = o0[q]; *(f32x4*)(F2 + 1 * SEQ + 16 * tid + 4 * q) = o1[q]; *(f32x4*)(F2 + 2 * SEQ + 16 * tid + 4 * q) = o2[q]; *(f32x4*)(F2 + 3 * SEQ + 16 * tid + 4 * q) = o3[q]; }
    __syncthreads();
}
constexpr int A_K = 0, A_V = 32768, A_F2K = 65536, A_BIAS = 66048, A_FLAGS = 67328, A_UNIT = 67456;
__device__ __forceinline__ int offb(int row, int ch) { return 256 * row + 16 * (ch ^ (((row & 3) << 2) | ((row >> 2) & 3))); }
__device__ __forceinline__ s16x4 vtr(LAS const unsigned char* p) { return __builtin_bit_cast(s16x4, __builtin_amdgcn_ds_read_tr16_b64_v4i16((LAS s16x4*)p)); }
#define MFMA32(a, b, c) __builtin_amdgcn_mfma_f32_32x32x16_bf16((a), (b), (c), 0, 0, 0)
template <int S> __device__ __forceinline__ bf16x8 pack8(const f32x16& x) {
    u32x4 p; p.x = pg8::pk_bf16(x[8 * S], x[8 * S + 1]); p.y = pg8::pk_bf16(x[8 * S + 2], x[8 * S + 3]); p.z = pg8::pk_bf16(x[8 * S + 4], x[8 * S + 5]); p.w = pg8::pk_bf16(x[8 * S + 6], x[8 * S + 7]);
    return __builtin_bit_cast(bf16x8, p);
}
constexpr float FOX_TH2 = 44.0f;
constexpr float SB_RMIN = 1e-20f;

template <int MODE  >
__device__ __forceinline__ void attn_unit(LAS unsigned char* lds, const bf16_t* __restrict__ Qp, const bf16_t* __restrict__ Kp, const bf16_t* __restrict__ Vp, bf16_t* __restrict__ Op,
                                          const int qb, const float* __restrict__ F2h, const float* __restrict__ relb, const float kbnd) {
    const int tid = tid_fresh(), lane = tid & 63, w = __builtin_amdgcn_readfirstlane(tid >> 6), r = lane & 31, hh = lane >> 5;
    const int twmin = qb * 256 + w * 32, twmax = twmin + 31, t = twmin + r;
    bf16x8 qf[8];
    { const bf16_t* qrow = Qp + (size_t)t * LDU + 8 * hh;
#pragma unroll
      for (int kk = 0; kk < 8; ++kk) qf[kk] = *(const bf16x8*)(qrow + 16 * kk); }
    f32x16 O[4];
#pragma unroll
    for (int d = 0; d < 4; ++d)
#pragma unroll
        for (int i = 0; i < 16; ++i) O[d][i] = 0.f;
    float m = -INFINITY, l = 0.f, R = 1.f, f2q = 0.f, qn = 0.f;
    if (MODE == 0) { f2q = F2h[t]; float s = 0.f;
#pragma unroll
        for (int kk = 0; kk < 8; ++kk)
#pragma unroll
            for (int j = 0; j < 8; ++j) { const float v = bf2f((unsigned short)qf[kk][j]); s += v * v; }
        s += __shfl_xor(s, 32); qn = sqrtf(s) * kbnd; }
    LAS float* biasL = (LAS float*)(lds + A_BIAS);
    LAS unsigned* flags = (LAS unsigned*)(lds + A_FLAGS);
    if (MODE == 2) { for (int i = tid; i < 320; i += 512) biasL[i] = relb[i] * LOG2E; }
    const int jhi = 4 * qb + 3, jlo = (MODE == 2) ? (4 * qb - 8 > 0 ? 4 * qb - 8 : 0) : 0;
    const int srow = tid >> 4, sch = tid & 15, soff0 = offb(srow, sch), soff1 = offb(srow + 32, sch);
    const bf16_t* kg = Kp + (size_t)srow * LDU + 8 * sch; const bf16_t* vg = Vp + (size_t)srow * LDU + 8 * sch;
    u32x4 kr0, kr1, vr0, vr1; float f2r = 0.f;
#define A_LOADT(jt) do { const size_t o_ = (size_t)(jt) * 64 * LDU; kr0 = *(const u32x4*)(kg + o_); kr1 = *(const u32x4*)(kg + o_ + 32 * LDU); vr0 = *(const u32x4*)(vg + o_); vr1 = *(const u32x4*)(vg + o_ + 32 * LDU); \
        if (MODE == 0 && tid < 64) f2r = F2h[(jt) * 64 + tid]; } while (0)
#define A_STORET(b) do { *(LAS u32x4*)(lds + A_K + (b) * 16384 + soff0) = kr0; *(LAS u32x4*)(lds + A_K + (b) * 16384 + soff1) = kr1; *(LAS u32x4*)(lds + A_V + (b) * 16384 + soff0) = vr0; *(LAS u32x4*)(lds + A_V + (b) * 16384 + soff1) = vr1; \
        if (MODE == 0 && tid < 64) ((LAS float*)(lds + A_F2K + (b) * 256))[tid] = f2r; } while (0)
    A_LOADT(jhi); A_STORET(0);
    __syncthreads();
    const int xk = ((r & 3) << 2) | ((r >> 2) & 3);
    const int li = lane & 15, tq = li >> 2, tp = li & 3, rh = (lane >> 4) & 1;
    int buf = 0, it = 0; bool wdone = false;
    for (int jt = jhi; jt >= jlo; --jt, ++it) {
        const bool more = jt > jlo;
        if (more) A_LOADT(jt - 1);
        const int kb = jt * 64;
        bool active;
        if (MODE == 0) active = (kb <= twmax) && !wdone;
        else if (MODE == 1) active = (kb < twmax) && !wdone;
        else { const int cw = 4 * qb + (w >> 1); active = (jt <= cw) && (jt >= cw - 8); }
        if (active) {
            LAS const unsigned char* Kb = lds + A_K + buf * 16384; LAS const unsigned char* Vb = lds + A_V + buf * 16384;
            f32x16 X[2];
#pragma unroll
            for (int i = 0; i < 16; ++i) { X[0][i] = 0.f; X[1][i] = 0.f; }
#pragma unroll
            for (int kk = 0; kk < 8; ++kk) { const int o = 256 * r + 16 * ((2 * kk + hh) ^ xk);
                const bf16x8 k0 = *(LAS const bf16x8*)(Kb + o), k1 = *(LAS const bf16x8*)(Kb + o + 8192);
                X[0] = MFMA32(k0, qf[kk], X[0]); X[1] = MFMA32(k1, qf[kk], X[1]); }
            if (MODE == 0 || MODE == 2) {
                float mx = -INFINITY;
                if (MODE == 0) { LAS const float* f2k = (LAS const float*)(lds + A_F2K + buf * 256); const bool needmask = (kb + 63 > twmin);
#pragma unroll
                    for (int b = 0; b < 2; ++b)
#pragma unroll
                        for (int g = 0; g < 4; ++g) { const f32x4 fk = *(LAS const f32x4*)(f2k + 32 * b + 8 * g + 4 * hh);
#pragma unroll
                            for (int c = 0; c < 4; ++c) { float s = X[b][4 * g + c] + (f2q - fk[c]); if (needmask && (kb + 32 * b + 8 * g + 4 * hh + c > t)) s = -INFINITY; X[b][4 * g + c] = s; mx = fmaxf(mx, s); } }
                } else {
#pragma unroll
                    for (int b = 0; b < 2; ++b)
#pragma unroll
                        for (int i = 0; i < 16; ++i) { const int key = kb + 32 * b + 8 * (i >> 2) + 4 * hh + (i & 3); int dist = t - key; dist = dist < -63 ? -63 : (dist > 256 ? 256 : dist);
                            const float s = X[b][i] + biasL[dist + 63]; X[b][i] = s; mx = fmaxf(mx, s); }
                }
                mx = fmaxf(mx, __shfl_xor(mx, 32));
                const float mnew = fmaxf(m, mx), msafe = (mnew == -INFINITY) ? 0.f : mnew;
                const float alpha = __builtin_amdgcn_exp2f(m - msafe);
                float ps = 0.f;
#pragma unroll
                for (int b = 0; b < 2; ++b)
#pragma unroll
                    for (int i = 0; i < 16; ++i) { const float p = __builtin_amdgcn_exp2f(X[b][i] - msafe); X[b][i] = p; ps += p; }
                l = l * alpha + ps; m = mnew;
                if (!__all(alpha == 1.0f)) {
#pragma unroll
                    for (int d = 0; d < 4; ++d)
#pragma unroll
                        for (int i = 0; i < 16; ++i) O[d][i] *= alpha; }
            } else {
                const bool needmask = (kb + 63 >= twmin);
                f32x16 OM[2];
#pragma unroll
                for (int b = 0; b < 2; ++b)
#pragma unroll
                    for (int i = 0; i < 16; ++i) { const float e = __builtin_amdgcn_exp2f(fminf(X[b][i], 115.0f)); float omb = __builtin_amdgcn_rcpf(1.0f + e); float beta = e * omb;
                        if (needmask && (kb + 32 * b + 8 * (i >> 2) + 4 * hh + (i & 3) >= t)) { omb = 1.0f; beta = 0.f; }
                        OM[b][i] = omb; X[b][i] = beta; }
                float Rr = R;
#pragma unroll
                for (int b = 1; b >= 0; --b)
#pragma unroll
                    for (int g = 3; g >= 0; --g) { const float G = (OM[b][4 * g] * OM[b][4 * g + 1]) * (OM[b][4 * g + 2] * OM[b][4 * g + 3]); const float Gp = __shfl_xor(G, 32);
                        const float E = hh ? Rr : Rr * Gp; Rr = Rr * (G * Gp);
                        const float w3 = E, w2 = w3 * OM[b][4 * g + 3], w1 = w2 * OM[b][4 * g + 2], w0 = w1 * OM[b][4 * g + 1];
                        X[b][4 * g + 3] *= w3; X[b][4 * g + 2] *= w2; X[b][4 * g + 1] *= w1; X[b][4 * g] *= w0; }
                R = Rr;
            }
            const bf16x8 p00 = pack8<0>(X[0]), p01 = pack8<1>(X[0]), p10 = pack8<0>(X[1]), p11 = pack8<1>(X[1]);
#pragma unroll
            for (int db = 0; db < 4; ++db) {
#pragma unroll
                for (int bs = 0; bs < 4; ++bs) {
                    s16x4 v[2];
#pragma unroll
                    for (int jj = 0; jj < 2; ++jj) { const int xr = (tq << 2) | (2 * jj + hh); const int ch = (4 * db + 2 * rh + (tp >> 1)) ^ xr;
                        v[jj] = vtr(Vb + 256 * (16 * bs + 8 * jj + 4 * hh + tq) + 16 * ch + 8 * (tp & 1)); }
                    bf16x8 vf; vf[0] = v[0][0]; vf[1] = v[0][1]; vf[2] = v[0][2]; vf[3] = v[0][3]; vf[4] = v[1][0]; vf[5] = v[1][1]; vf[6] = v[1][2]; vf[7] = v[1][3];
                    O[db] = MFMA32(vf, bs == 0 ? p00 : (bs == 1 ? p01 : (bs == 2 ? p10 : p11)), O[db]); } }
            if (MODE == 0) { const float fk0 = ((LAS const float*)(lds + A_F2K + buf * 256))[0]; wdone = __all((qn + f2q - fk0 - m) < -FOX_TH2); }
            if (MODE == 1) wdone = __all(R < SB_RMIN);
        }
        if (more) A_STORET(buf ^ 1);
        if (MODE != 2) { if (lane == 0) flags[(it & 1) * 8 + w] = wdone ? 1u : 0u; }
        __syncthreads();
        if (MODE != 2) { unsigned a = 1u;
#pragma unroll
            for (int i = 0; i < 8; ++i) a &= flags[(it & 1) * 8 + i];
            if (a) break; }
        buf ^= 1;
    }
#undef A_LOADT
#undef A_STORET
    float sc = 1.0f;
    if (MODE != 1) { const float lt = l + __shfl_xor(l, 32); sc = 1.0f / lt; }
    bf16_t* orow = Op + (size_t)t * WBR + 4 * hh;
#pragma unroll
    for (int db = 0; db < 4; ++db)
#pragma unroll
        for (int g = 0; g < 4; ++g) { u32x2 o; o.x = pg8::pk_bf16(O[db][4 * g] * sc, O[db][4 * g + 1] * sc); o.y = pg8::pk_bf16(O[db][4 * g + 2] * sc, O[db][4 * g + 3] * sc);
            *(u32x2*)(orow + 32 * db + 8 * g) = o; }
}
constexpr int L_WR = 0, L_WI = 8704, L_RAW = 17408, L_XC = 50944, L_A = 85760, L_INP = 102144, L_RY = 118528, L_AH = 126720, L_CARRY = 130816, L_PAR = 131072;
__device__ __forceinline__ float gelu_tanh(float y) { const float u = 0.7978845608028654f * (y + 0.044715f * y * y * y); const float th = 1.0f - 2.0f / (1.0f + __expf(2.0f * u)); return 0.5f * y * (1.0f + th); }
typedef __attribute__((address_space(1))) unsigned long long gu64;
__device__ __forceinline__ void lru_unit(LAS unsigned char* lds, const int l, const int n, const int cs, const int sg, const bf16_t* __restrict__ U, bf16_t* __restrict__ Oout, unsigned long long* pub) {
    const int tid = tid_fresh(), lane = tid & 63, w = __builtin_amdgcn_readfirstlane(tid >> 6);
    const int ch0 = n * 128, oc0 = ch0 + 32 * cs, t0 = sg * 128;
    LAS float* par = (LAS float*)(lds + L_PAR);
    LAS float* carry = (LAS float*)(lds + L_CARRY);
    gu64* gran = (gu64*)pub + (size_t)((l * 16 + n * 4 + cs) * 64) * 64;
    {
        KArgP k = kargs(); Ptrs P; P.w_r = k->in[7]; P.b_r = k->in[8]; P.w_i = k->in[9]; P.b_i = k->in[10]; P.lam = k->in[11]; P.conv_w = k->in[5]; P.conv_b = k->in[6];
        const float* wr = P.w_r + (size_t)(l * 4 + n) * 128 * 128; const float* wi = P.w_i + (size_t)(l * 4 + n) * 128 * 128;
        for (int idx = tid; idx < 128 * 32; idx += 512) { const int c = idx >> 5, d = idx & 31;
            *(LAS unsigned short*)(lds + L_WR + d * 272 + 2 * c) = (unsigned short)f2bf(wr[c * 128 + 32 * cs + d]);
            *(LAS unsigned short*)(lds + L_WI + d * 272 + 2 * c) = (unsigned short)f2bf(wi[c * 128 + 32 * cs + d]); }
        if (tid < 32) { par[tid] = 8.0f * log_sigmoid(P.lam[l * 512 + oc0 + tid]); par[32 + tid] = P.b_r[l * 512 + oc0 + tid]; par[64 + tid] = P.b_i[l * 512 + oc0 + tid]; }
        if (tid < 128) { par[96 + tid] = P.conv_b[l * 512 + ch0 + tid];
#pragma unroll
            for (int j = 0; j < 4; ++j) par[224 + j * 128 + tid] = P.conv_w[(size_t)(l * 4 + j) * 512 + ch0 + tid]; }
    }
    {
        const bf16_t* rxg = U + 1536 + ch0; const bf16_t* ryg = U + 2048 + oc0;
#pragma unroll
        for (int i = 0; i < 5; ++i) { const int cidx = tid + 512 * i; const int row = cidx >> 4, ch = cidx & 15; const int tt = t0 - 3 + row;
            u32x4 v = (u32x4){0u, 0u, 0u, 0u}; if (row < 131 && tt >= 0) v = *(const u32x4*)(rxg + (size_t)tt * LDU + 8 * ch);
            if (cidx < 131 * 16) *(LAS u32x4*)(lds + L_RAW + cidx * 16) = v; }
        *(LAS u32x4*)(lds + L_RY + tid * 16) = *(const u32x4*)(ryg + (size_t)(t0 + (tid >> 2)) * LDU + 8 * (tid & 3));
    }
    __syncthreads();
    { const int tok = tid >> 2, qd = tid & 3;
#pragma unroll
      for (int v = 0; v < 4; ++v) { const int c0 = 32 * qd + 8 * v; float xc[8];
#pragma unroll
          for (int e = 0; e < 8; ++e) xc[e] = par[96 + c0 + e];
#pragma unroll
          for (int j = 0; j < 4; ++j) { const u32x4 rw = *(LAS const u32x4*)(lds + L_RAW + (tok + j) * 256 + 2 * c0);
              const unsigned ww[4] = {rw.x, rw.y, rw.z, rw.w};
#pragma unroll
              for (int e = 0; e < 4; ++e) { xc[2 * e] += __uint_as_float(ww[e] << 16) * par[224 + j * 128 + c0 + 2 * e]; xc[2 * e + 1] += __uint_as_float(ww[e] & 0xffff0000u) * par[224 + j * 128 + c0 + 2 * e + 1]; } }
          u32x4 o; o.x = pk2(xc[0], xc[1]); o.y = pk2(xc[2], xc[3]); o.z = pk2(xc[4], xc[5]); o.w = pk2(xc[6], xc[7]);
          *(LAS u32x4*)(lds + L_XC + tok * 272 + 2 * c0) = o; } }
    __syncthreads();
    { const int fr = lane & 15, fq = lane >> 4;
      f32x4 ar[2], ai[2];
#pragma unroll
      for (int ct = 0; ct < 2; ++ct) { ar[ct] = (f32x4){0.f, 0.f, 0.f, 0.f}; ai[ct] = (f32x4){0.f, 0.f, 0.f, 0.f}; }
#pragma unroll
      for (int kk = 0; kk < 4; ++kk) { const bf16x8 a = *(LAS const bf16x8*)(lds + L_XC + (16 * w + fr) * 272 + 2 * (32 * kk + 8 * fq));
#pragma unroll
          for (int ct = 0; ct < 2; ++ct) { const bf16x8 br_ = *(LAS const bf16x8*)(lds + L_WR + (16 * ct + fr) * 272 + 2 * (32 * kk + 8 * fq)); const bf16x8 bi_ = *(LAS const bf16x8*)(lds + L_WI + (16 * ct + fr) * 272 + 2 * (32 * kk + 8 * fq));
              ar[ct] = __builtin_amdgcn_mfma_f32_16x16x32_bf16(a, br_, ar[ct], 0, 0, 0); ai[ct] = __builtin_amdgcn_mfma_f32_16x16x32_bf16(a, bi_, ai[ct], 0, 0, 0); } }
#pragma unroll
      for (int ct = 0; ct < 2; ++ct) { const int d = 16 * ct + fr, c = 32 * cs + d;
#pragma unroll
          for (int rg = 0; rg < 4; ++rg) { const int tt = 16 * w + 4 * fq + rg;
              const float rgate = pg8::sigmoidf_(ar[ct][rg] + par[32 + d]), igate = pg8::sigmoidf_(ai[ct][rg] + par[64 + d]);
              const float la = rgate * par[d]; const float a = __expf(la); const float mult = sqrtf(fmaxf(-expm1f(2.0f * la), 0.f));
              float xcf = par[96 + c];
#pragma unroll
              for (int j = 0; j < 4; ++j) xcf += bf2f(*(LAS const unsigned short*)(lds + L_RAW + (tt + j) * 256 + 2 * c)) * par[224 + j * 128 + c];
              ((LAS float*)(lds + L_A))[tt * 32 + d] = a; ((LAS float*)(lds + L_INP))[tt * 32 + d] = mult * igate * xcf; } } }
    __syncthreads();
    { const int d = tid & 31, sub = tid >> 5;
      LAS const float* Aa = (LAS const float*)(lds + L_A) + (8 * sub) * 32 + d; LAS const float* Ii = (LAS const float*)(lds + L_INP) + (8 * sub) * 32 + d;
      float av[8], iv[8], A = 1.f, H = 0.f;
#pragma unroll
      for (int i = 0; i < 8; ++i) { av[i] = Aa[i * 32]; iv[i] = Ii[i * 32]; H = av[i] * H + iv[i]; A *= av[i]; }
      LAS float* AH = (LAS float*)(lds + L_AH);
      AH[(sub * 32 + d) * 2] = A; AH[(sub * 32 + d) * 2 + 1] = H;
      __syncthreads();
      if (tid < 32) { float As = 1.f, Hs = 0.f;
#pragma unroll
          for (int s = 0; s < 16; ++s) { const float a_ = AH[(s * 32 + tid) * 2], h_ = AH[(s * 32 + tid) * 2 + 1]; Hs = a_ * Hs + h_; As *= a_; }
          __hip_atomic_store(gran + (size_t)sg * 64 + 2 * tid, (1ull << 32) | (unsigned long long)__float_as_uint(As), __ATOMIC_RELAXED, __HIP_MEMORY_SCOPE_AGENT);
          __hip_atomic_store(gran + (size_t)sg * 64 + 2 * tid + 1, (1ull << 32) | (unsigned long long)__float_as_uint(Hs), __ATOMIC_RELAXED, __HIP_MEMORY_SCOPE_AGENT); }
      LAS float* GA = (LAS float*)(lds + L_XC);
      for (int sp = w; sp < sg; sp += 8) { gu64* g = gran + (size_t)sp * 64 + lane; unsigned long long x; unsigned spins = 0;
          for (;;) { x = __hip_atomic_load(g, __ATOMIC_RELAXED, __HIP_MEMORY_SCOPE_AGENT); if (__all((unsigned)(x >> 32) == 1u)) break; if (++spins > (1u << 22)) break; __builtin_amdgcn_s_sleep(2); }
          GA[sp * 64 + lane] = __uint_as_float((unsigned)x); }
      __syncthreads();
      if (tid < 32) { float h = 0.f; for (int sp = 0; sp < sg; ++sp) h = GA[sp * 64 + 2 * tid] * h + GA[sp * 64 + 2 * tid + 1]; carry[tid] = h; }
      __syncthreads();
      float h = carry[d];
      for (int s = 0; s < sub; ++s) h = AH[(s * 32 + d) * 2] * h + AH[(s * 32 + d) * 2 + 1];
#pragma unroll
      for (int i = 0; i < 8; ++i) { h = av[i] * h + iv[i]; const int tt = 8 * sub + i;
          const float y = bf2f(*(LAS const unsigned short*)(lds + L_RY + tt * 64 + 2 * d));
          Oout[(size_t)(t0 + tt) * WBR + oc0 + d] = (unsigned short)f2bf(h * gelu_tanh(y)); } }
    __syncthreads();
}
constexpr int LDS_UNIT = 147392, CW_BAR = 4096;
__device__ __forceinline__ Ptrs make_ptrs(KArgP k) {
    Ptrs P;
    P.x = k->in[0]; P.ln_in_g = k->in[1]; P.ln_in_b = k->in[2]; P.w_in = k->in[3]; P.b_forget = k->in[4]; P.conv_w = k->in[5]; P.conv_b = k->in[6]; P.w_r = k->in[7]; P.b_r = k->in[8]; P.w_i = k->in[9]; P.b_i = k->in[10];
    P.lam = k->in[11]; P.rel_bias = k->in[12]; P.w_branch = k->in[13]; P.w_gate = k->in[14]; P.b_gate = k->in[15]; P.w_out = k->in[16]; P.ln1_g = k->in[17]; P.ln1_b = k->in[18]; P.w_ff1 = k->in[19]; P.w_ff2 = k->in[20];
    P.ln2_g = k->in[21]; P.ln2_b = k->in[22]; P.out = k->out; P.ws = k->ws;
    return P;
}
__global__ void __launch_bounds__(512, 2) fwd_megakernel(Args a_unused) {
    extern __shared__ __attribute__((aligned(16))) unsigned char lds_raw[];
    LAS unsigned char* lds = (LAS unsigned char*)lds_raw;
    cg::grid_group grid = cg::this_grid();
    if (threadIdx.x < 2) ((volatile LAS unsigned*)(lds + LDS_UNIT + 16))[threadIdx.x] = 0u;
    __syncthreads();
    const XcdBarrier bar = xcd_barrier_post((unsigned*)(kargs()->ws + WS_CTL) + CW_BAR, (volatile LAS unsigned*)(lds + LDS_UNIT + 16));
#define MK_IDS() const int tid = tid_fresh(), lane = tid & 63, wave = __builtin_amdgcn_readfirstlane(tid >> 6); const int G = gridDim.x, bx = blockIdx.x; \
    const int vcu = (G % 8 == 0) ? (bx % 8) * (G / 8) + bx / 8 : bx; const int gw = vcu * 8 + wave, ngw = G * 8; (void)lane; (void)gw; (void)ngw; (void)tid;
    { MK_IDS(); KArgP k = kargs(); const Ptrs P = make_ptrs(k);
      ((unsigned long long*)(P.ws + WS_PUB))[(size_t)bx * 512 + tid] = 0ull; if (G < 256) for (int i = G * 512 + bx * 512 + tid; i < 131072; i += G * 512) ((unsigned long long*)(P.ws + WS_PUB))[i] = 0ull;
      convert_weights(P, 0, lds, gw, ngw, wave, lane);
      ln_rows(P.x, P.ln_in_g, P.ln_in_b, P.out, (bf16_t*)(P.ws + WS_XN), P.w_in + 1536, P.b_forget, (float*)(P.ws + WS_LF), gw, ngw, lane); }
    grid.sync();
#pragma unroll 1
    for (int l = 0; l < 2; ++l) {
        { MK_IDS(); KArgP k = kargs(); unsigned char* ws = k->ws;
          if (bx == G - 1) cumsum_f((const float*)(ws + WS_LF), (float*)(ws + WS_F2), lds, tid);
          pg8::Gemm g{(const bf16_t*)(ws + WS_XN), (const bf16_t*)(ws + WS_WIN), SEQ, NBIG, DM}; pg8::StaticOrder S; S.init(SEQ, NBIG, G, bx);
          pg8::EpiIn E{(bf16_t*)(ws + WS_U), (bf16_t*)(ws + WS_GH), k->in[15] + (size_t)l * 4 * DM, (unsigned*)(ws + WS_CTL) + 16 + 16 * l, C2};
          pg8::gemm_phase<pg8::EpiIn, pg8::StaticOrder, true, true>(lds, g, S, E); }
        xcd_barrier(bar);
        { MK_IDS(); KArgP k = kargs(); unsigned char* ws = k->ws; unsigned* ctl = (unsigned*)(ws + WS_CTL);
          const bf16_t* U = (const bf16_t*)(ws + WS_U); bf16_t* OALL = (bf16_t*)(ws + WS_OALL); const float* F2 = (const float*)(ws + WS_F2);
            for (;;) {
                if (tid == 0) *(LAS int*)(lds + LDS_UNIT) = (int)atomicAdd(ctl + l, 1u);
                __syncthreads();
                const int unit = __builtin_amdgcn_readfirstlane(*(LAS int*)(lds + LDS_UNIT));
                __syncthreads();
                if (unit >= NUNITS_MIX) break;
                if (unit < 128) { const int kq = unit, qb = 31 - (kq >> 2), h = kq & 3;
                    float s = 0.f;
#pragma unroll
                    for (int c = 0; c < 4; ++c) s += __uint_as_float(__hip_atomic_load(ctl + 16 + 16 * l + h * 4 + c, __ATOMIC_RELAXED, __HIP_MEMORY_SCOPE_AGENT));
                    attn_unit<0>(lds, U + h * HD, U + 512 + h * HD, U + 1024 + h * HD, OALL + h * HD, qb, F2 + (size_t)h * SEQ, nullptr, sqrtf(s) * 1.02f); }
                else if (unit < 256) { const int kq = unit - 128, qb = kq >> 2, h = kq & 3;
                    attn_unit<2>(lds, U + 4096 + h * HD, U + 4608 + h * HD, U + 5120 + h * HD, OALL + (size_t)3 * SEQ * WBR + h * HD, qb, nullptr, kargs()->in[12] + (size_t)(l * 4 + h) * 320, 0.f); }
                else if (unit < 1280) { const int kq = unit - 256; lru_unit(lds, l, (kq >> 2) & 3, kq & 3, kq >> 4, U, OALL + (size_t)1 * SEQ * WBR, (unsigned long long*)(ws + WS_PUB)); }
                else { const int kq = unit - 1280, qb = kq >> 2, h = kq & 3;
                    attn_unit<1>(lds, U + 2560 + h * HD, U + 3072 + h * HD, U + 3584 + h * HD, OALL + (size_t)2 * SEQ * WBR + h * HD, qb, nullptr, nullptr, 0.f); }
            }
        }
        xcd_barrier(bar);
        { MK_IDS(); KArgP k = kargs(); unsigned char* ws = k->ws;
          pg8::Gemm g{(const bf16_t*)(ws + WS_OALL), (const bf16_t*)(ws + WS_WB), SEQ, DM, WBR}; pg8::BranchOrder S{G, bx};
          pg8::EpiBranch E{(const bf16_t*)(ws + WS_GH), (float*)(ws + WS_MFY), (bf16_t*)(ws + WS_MB)};
          pg8::gemm_phase<pg8::EpiBranch, pg8::BranchOrder, true, true>(lds, g, S, E); }
        xcd_barrier(bar);
        { MK_IDS(); KArgP k = kargs(); unsigned char* ws = k->ws;
          pg8::Gemm g{(const bf16_t*)(ws + WS_MB), (const bf16_t*)(ws + WS_WO), SEQ, DM, DM}; pg8::StaticOrder S; S.init(SEQ, DM, G, bx);
          pg8::EpiResid E{k->out, (float*)(ws + WS_MFY), ALPHA};
          pg8::gemm_phase<pg8::EpiResid, pg8::StaticOrder, true, true>(lds, g, S, E); }
        xcd_barrier(bar);
        { MK_IDS(); KArgP k = kargs(); unsigned char* ws = k->ws;
          ln_rows((const float*)(ws + WS_MFY), k->in[17] + (size_t)l * DM, k->in[18] + (size_t)l * DM, k->out, (bf16_t*)(ws + WS_XN), nullptr, nullptr, nullptr, gw, ngw, lane); }
        xcd_barrier(bar);
        { MK_IDS(); KArgP k = kargs(); unsigned char* ws = k->ws;
          pg8::Gemm g{(const bf16_t*)(ws + WS_XN), (const bf16_t*)(ws + WS_W1), SEQ, DFF, DM}; pg8::StaticOrder S; S.init(SEQ, DFF, G, bx);
          pg8::EpiRelu2 E{(bf16_t*)(ws + WS_GH)};
          pg8::gemm_phase<pg8::EpiRelu2, pg8::StaticOrder, true, true>(lds, g, S, E); }
        xcd_barrier(bar);
        { MK_IDS(); KArgP k = kargs(); unsigned char* ws = k->ws;
          pg8::Gemm g{(const bf16_t*)(ws + WS_GH), (const bf16_t*)(ws + WS_W2), SEQ, DM, DFF}; pg8::StaticOrder S; S.init(SEQ, DM, G, bx);
          pg8::EpiResid E{k->out, (float*)(ws + WS_MFY), ALPHA};
          pg8::gemm_phase<pg8::EpiResid, pg8::StaticOrder, true, true>(lds, g, S, E); }
        xcd_barrier(bar);
        { MK_IDS(); KArgP k = kargs(); const Ptrs P = make_ptrs(k); unsigned char* ws = P.ws;
          if (l == 0) {
            ln_rows((const float*)(ws + WS_MFY), P.ln2_g, P.ln2_b, P.out, (bf16_t*)(ws + WS_XN), P.w_in + (size_t)DM * DIN + 1536, P.b_forget + 4, (float*)(ws + WS_LF), gw, ngw, lane);
            convert_weights(P, 1, lds, gw, ngw, wave, lane);
          } else {
            ln_rows((const float*)(ws + WS_MFY), P.ln2_g + DM, P.ln2_b + DM, P.out, (bf16_t*)(ws + WS_XN), nullptr, nullptr, nullptr, gw, ngw, lane);
          } }
        if (l == 0) xcd_barrier(bar);
    }
}
}

extern "C" void kernel_launch(void* const* d_in, const int* in_sizes, int n_in, void* d_out, int out_size, void* d_ws, size_t ws_size, hipStream_t stream) {
    static int grid = 0;
    if (grid == 0) {
        if (n_in != 23 || out_size != mk::SEQ * mk::DM || ws_size < mk::WS_END) { fprintf(stderr, "kernel_launch: unexpected problem (n_in %d, out %d, ws %zu)\n", n_in, out_size, ws_size); grid = -1; return; }
        int dev = 0, cus = 0, per_cu = 0;
        hipGetDevice(&dev); hipDeviceGetAttribute(&cus, hipDeviceAttributeMultiprocessorCount, dev);
        if (hipFuncSetAttribute((const void*)mk::fwd_megakernel, hipFuncAttributeMaxDynamicSharedMemorySize, mk::LDS_BYTES) != hipSuccess) { fprintf(stderr, "kernel_launch: hipFuncSetAttribute failed\n"); grid = -1; return; }
        if (hipOccupancyMaxActiveBlocksPerMultiprocessor(&per_cu, (const void*)mk::fwd_megakernel, 512, mk::LDS_BYTES) != hipSuccess || per_cu < 1) { fprintf(stderr, "kernel_launch: occupancy query gave %d\n", per_cu); per_cu = 1; (void)hipGetLastError(); }
        grid = cus * per_cu;
    }
    if (grid < 0) return;
    (void)hipMemsetAsync((char*)d_ws + mk::WS_CTL, 0, 65536, stream);
    mk::Args a{};
    for (int i = 0; i < 23; ++i) a.in[i] = (const float*)d_in[i];
    a.out = (float*)d_out; a.ws = (unsigned char*)d_ws;
    void* args[] = {&a};
    hipError_t e = hipLaunchCooperativeKernel((const void*)mk::fwd_megakernel, dim3(grid), dim3(512), args, mk::LDS_BYTES, stream);
    if (e != hipSuccess) fprintf(stderr, "cooperative launch failed: %s (grid %d)\n", hipGetErrorString(e), grid);
}
```
